# Optimizing an MI355X kernel written in HIP

```python
import math
import jax, jax.numpy as jnp
from jax import lax
import numpy as np

D_MODEL = 1024
BATCH = 1
SEQ = 16384
DEPTH = 4

A_HEADS = 8
A_HEAD_DIM = 64
A_QK = A_HEADS * 2 * A_HEAD_DIM
A_V = A_HEADS * 2 * A_HEAD_DIM
Q_BLOCK = 128
M_HEADS = 4
M_INNER = D_MODEL
M_HEAD_DIM = M_INNER // M_HEADS
CONV_WIDTH = 4
CHUNK = 64
NUM_BUCKETS = 32
MAX_DISTANCE = 128
D_FF = 4 * D_MODEL
N_IN = 2 * A_QK + A_V + 4 * M_INNER + 2 * M_HEADS + 2 * D_MODEL
EPS = 1e-6

kernel_name = "hybrid_diffattn_mlstm_gated_block"


def rms_norm(x, g):
    xf = x.astype(jnp.float32)
    y = xf * lax.rsqrt(jnp.mean(xf * xf, axis=-1, keepdims=True) + EPS)
    return (y * g.astype(jnp.float32)).astype(x.dtype)


def t5_bucket(dist):
    max_exact = NUM_BUCKETS // 2
    nf = jnp.maximum(dist, 1).astype(jnp.float32)
    large = max_exact + (jnp.log(nf / max_exact) / math.log(MAX_DISTANCE / max_exact)
                         * (NUM_BUCKETS - max_exact)).astype(jnp.int32)
    large = jnp.minimum(large, NUM_BUCKETS - 1)
    return jnp.where(dist < max_exact, dist, large)


def causal_conv(u, w, b):
    s = u.shape[1]
    up = jnp.pad(u, ((0, 0), (CONV_WIDTH - 1, 0), (0, 0)))
    y = b
    for j in range(CONV_WIDTH):
        y = y + w[j] * up[:, j:j + s]
    return y


def diff_attention(q1, q2, k1, k2, v, lam, bias_by_dist):
    b, h, s, dh = q1.shape
    nb = s // Q_BLOCK
    scale = A_HEAD_DIM ** -0.5
    kpos = jnp.arange(s)

    def block(args):
        q1b, q2b, start = args
        qpos = start + jnp.arange(Q_BLOCK)
        dist = qpos[:, None] - kpos[None, :]
        causal = dist >= 0
        bias = jnp.take(bias_by_dist, jnp.clip(dist, 0, s - 1), axis=1)[None]

        def probs(qb, kk):
            logits = jnp.einsum('bhqd,bhkd->bhqk', qb, kk).astype(jnp.float32) * scale + bias
            logits = jnp.where(causal, logits, -jnp.inf)
            return jax.nn.softmax(logits, axis=-1)

        p = probs(q1b, k1) - lam * probs(q2b, k2)
        return jnp.einsum('bhqk,bhkd->bhqd', p.astype(v.dtype), v)

    to_blocks = lambda t: t.reshape(b, h, nb, Q_BLOCK, dh).transpose(2, 0, 1, 3, 4)
    starts = jnp.arange(nb) * Q_BLOCK
    out = lax.map(block, (to_blocks(q1), to_blocks(q2), starts))
    return out.transpose(1, 2, 0, 3, 4).reshape(b, h, s, v.shape[-1])


def mlstm_chunkwise(q, k, v, i_pre, f_pre):
    out_dtype = q.dtype
    b, nh, s, dh = q.shape
    nc = s // CHUNK
    qf = q.astype(jnp.float32)
    kf = k.astype(jnp.float32) * (dh ** -0.5)
    vf = v.astype(jnp.float32)
    ig = i_pre.astype(jnp.float32)
    logf = jax.nn.log_sigmoid(f_pre.astype(jnp.float32))
    chunk4 = lambda t: jnp.moveaxis(t.reshape(b, nh, nc, CHUNK, dh), 2, 0)
    chunk3 = lambda t: jnp.moveaxis(t.reshape(b, nh, nc, CHUNK), 2, 0)
    tril = jnp.tril(jnp.ones((CHUNK, CHUNK), dtype=bool))

    def step(carry, inp):
        cmat, nvec, m = carry
        qc, kc, vc, ic, lfc = inp
        bcum = jnp.cumsum(lfc, axis=-1)
        dmat = bcum[..., :, None] - bcum[..., None, :] + ic[..., None, :]
        dmat = jnp.where(tril, dmat, -jnp.inf)
        inter = bcum + m[..., None]
        m_t = jnp.maximum(jnp.max(dmat, axis=-1), inter)
        scores = jnp.einsum('bhtd,bhsd->bhts', qc, kc) * jnp.exp(dmat - m_t[..., None])
        a_inter = jnp.exp(inter - m_t)
        num = (jnp.einsum('bhts,bhsd->bhtd', scores, vc)
               + a_inter[..., None] * jnp.einsum('bhed,bhtd->bhte', cmat, qc))
        den = jnp.sum(scores, axis=-1) + a_inter * jnp.einsum('bhd,bhtd->bht', nvec, qc)
        h = num / jnp.maximum(jnp.abs(den), jnp.exp(-m_t))[..., None]
        b_last = bcum[..., -1]
        g = b_last[..., None] - bcum + ic
        m_new = jnp.maximum(b_last + m, jnp.max(g, axis=-1))
        wk = jnp.exp(g - m_new[..., None])
        decay = jnp.exp(b_last + m - m_new)
        c_new = decay[..., None, None] * cmat + jnp.einsum('bhs,bhse,bhsd->bhed', wk, vc, kc)
        n_new = decay[..., None] * nvec + jnp.einsum('bhs,bhsd->bhd', wk, kc)
        return (c_new, n_new, m_new), h

    init = (jnp.zeros((b, nh, dh, dh), jnp.float32),
            jnp.zeros((b, nh, dh), jnp.float32),
            jnp.zeros((b, nh), jnp.float32))
    _, hs = lax.scan(step, init, (chunk4(qf), chunk4(kf), chunk4(vf), chunk3(ig), chunk3(logf)))
    return jnp.moveaxis(hs, 0, 2).reshape(b, nh, s, dh).astype(out_dtype)


def setup_inputs(seed: int = 0) -> dict:
    key = jax.random.key(seed)
    ks = jax.random.split(key, 24)
    nrm = lambda k, shape, sc: jax.random.normal(k, shape, jnp.float32) * sc
    gain = lambda k, shape: 1.0 + 0.02 * jax.random.normal(k, shape, jnp.float32)
    return {
        "x": nrm(ks[0], (BATCH, SEQ, D_MODEL), 1.0),
        "c": nrm(ks[1], (BATCH, D_MODEL), 1.0),
        "w_ada": nrm(ks[2], (DEPTH, D_MODEL, 6 * D_MODEL), 0.5 * D_MODEL ** -0.5),
        "b_ada": nrm(ks[3], (DEPTH, 6 * D_MODEL), 0.02),
        "norm_mix_g": gain(ks[4], (DEPTH, D_MODEL)),
        "norm_ffn_g": gain(ks[5], (DEPTH, D_MODEL)),
        "w_in": nrm(ks[6], (DEPTH, D_MODEL, N_IN), D_MODEL ** -0.5),
        "b_igate": nrm(ks[7], (DEPTH, M_HEADS), 0.1),
        "b_fgate": jnp.linspace(3.0, 6.0, M_HEADS, dtype=jnp.float32)[None, :] + nrm(ks[8], (DEPTH, M_HEADS), 0.1),
        "qn_g": gain(ks[9], (DEPTH, A_HEAD_DIM)),
        "kn_g": gain(ks[10], (DEPTH, A_HEAD_DIM)),
        "lam_qk": nrm(ks[11], (DEPTH, 4, A_HEAD_DIM), 0.1),
        "subln_g": gain(ks[12], (DEPTH, 2 * A_HEAD_DIM)),
        "rel_table": nrm(ks[13], (NUM_BUCKETS, A_HEADS), 0.5),
        "conv_w": nrm(ks[14], (DEPTH, CONV_WIDTH, 2 * M_INNER), CONV_WIDTH ** -0.5),
        "conv_b": nrm(ks[15], (DEPTH, 2 * M_INNER), 0.02),
        "mhn_g": gain(ks[16], (DEPTH, M_HEAD_DIM)),
        "w_a": nrm(ks[17], (DEPTH, A_V, D_MODEL), A_V ** -0.5),
        "w_m": nrm(ks[18], (DEPTH, M_INNER, D_MODEL), M_INNER ** -0.5),
        "w_out": nrm(ks[19], (DEPTH, D_MODEL, D_MODEL), D_MODEL ** -0.5),
        "w_ff1": nrm(ks[20], (DEPTH, D_MODEL, D_FF), D_MODEL ** -0.5),
        "w_ff2": nrm(ks[21], (DEPTH, D_FF, D_MODEL), D_FF ** -0.5),
    }


def reference(x, c, w_ada, b_ada, norm_mix_g, norm_ffn_g, w_in, b_igate, b_fgate, qn_g, kn_g,
              lam_qk, subln_g, rel_table, conv_w, conv_b, mhn_g, w_a, w_m, w_out, w_ff1, w_ff2):
    b, s, _ = x.shape
    bias_by_dist = rel_table[t5_bucket(jnp.arange(s))].T.astype(jnp.float32)
    cond = jax.nn.silu(c)
    sizes = [A_QK, A_QK, A_V, M_INNER, M_INNER, M_INNER, M_INNER, M_HEADS, M_HEADS, D_MODEL, D_MODEL]
    points = []
    acc = 0
    for sz in sizes[:-1]:
        acc += sz
        points.append(acc)
    m_heads = lambda t: t.reshape(b, s, M_HEADS, M_HEAD_DIM).transpose(0, 2, 1, 3)

    for l in range(DEPTH):
        lam_init = 0.8 - 0.6 * math.exp(-0.3 * l)
        mod = cond @ w_ada[l] + b_ada[l]
        sh_a, sc_a, gt_a, sh_f, sc_f, gt_f = jnp.split(mod[:, None, :], 6, axis=-1)

        h = rms_norm(x, norm_mix_g[l]) * (1.0 + sc_a) + sh_a
        proj = h @ w_in[l]
        aq, ak, av, mq, mk, mv, mo, mi, mf, ga, gm = jnp.split(proj, points, axis=-1)

        aq = rms_norm(aq.reshape(b, s, A_HEADS, 2, A_HEAD_DIM).transpose(3, 0, 2, 1, 4), qn_g[l])
        ak = rms_norm(ak.reshape(b, s, A_HEADS, 2, A_HEAD_DIM).transpose(3, 0, 2, 1, 4), kn_g[l])
        av = av.reshape(b, s, A_HEADS, 2 * A_HEAD_DIM).transpose(0, 2, 1, 3)
        lq = lam_qk[l].astype(jnp.float32)
        lam = jnp.exp(jnp.sum(lq[0] * lq[1])) - jnp.exp(jnp.sum(lq[2] * lq[3])) + lam_init
        ya = diff_attention(aq[0], aq[1], ak[0], ak[1], av, lam, bias_by_dist)
        ya = rms_norm(ya, subln_g[l]) * (1.0 - lam_init)
        ya = ya.transpose(0, 2, 1, 3).reshape(b, s, A_V)

        qk_m = jax.nn.silu(causal_conv(jnp.concatenate([mq, mk], axis=-1), conv_w[l], conv_b[l]))
        mq, mk = jnp.split(qk_m, 2, axis=-1)
        hm = mlstm_chunkwise(m_heads(mq), m_heads(mk), m_heads(mv),
                             (mi + b_igate[l]).transpose(0, 2, 1), (mf + b_fgate[l]).transpose(0, 2, 1))
        hm = rms_norm(hm, mhn_g[l]).transpose(0, 2, 1, 3).reshape(b, s, M_INNER)
        ym = jax.nn.sigmoid(mo) * hm

        merged = jax.nn.sigmoid(ga) * (ya @ w_a[l]) + jax.nn.sigmoid(gm) * (ym @ w_m[l])
        x = x + gt_a * (merged @ w_out[l])

        h = rms_norm(x, norm_ffn_g[l]) * (1.0 + sc_f) + sh_f
        x = x + gt_f * (jnp.square(jax.nn.relu(h @ w_ff1[l])) @ w_ff2[l])
    return x
```

```cpp
#include <hip/hip_runtime.h>
#include <cstdio>
#include <cstdint>
#include <cmath>

constexpr int S_ = 16384, DM_ = 1024, DEPTH_ = 4, NIN_SRC = 9224, NIN_ = 9216, GATE_COL = 7168, DFF_ = 4096;
constexpr float EPS_ = 1e-6f;
constexpr float LOG2E_ = 1.4426950408889634f;
constexpr float C2Q_ = 0.125f * 1.4426950408889634f;

constexpr size_t EP_Q = 80u << 20, EP_K = 112u << 20, EP_V8T = 128u << 20, EP_V = 144u << 20, EP_MQKR = 176u << 20, EP_MV = 240u << 20, EP_MO = 272u << 20, EP_GAM = 304u << 20;

#ifndef DBG_ATT_SCALE
#define DBG_ATT_SCALE 1.0f
#endif
#ifndef DBG_MLS_SCALE
#define DBG_MLS_SCALE 1.0f
#endif
__device__ __forceinline__ int lane_id_opaque() { int l; asm volatile("v_mbcnt_lo_u32_b32 %0, -1, 0\n\tv_mbcnt_hi_u32_b32 %0, -1, %0" : "=v"(l)); return l; }
template <int M> __device__ __forceinline__ float swz_xor(float v) { static_assert(M >= 1 && M < 32, "xor inside a 32-lane half"); return __uint_as_float((unsigned)__builtin_amdgcn_ds_swizzle((int)__float_as_uint(v), (M << 10) | 0x1f)); }
__device__ __forceinline__ void halves(float v, float& lo, float& hi) { auto rr = __builtin_amdgcn_permlane32_swap(__float_as_uint(v), __float_as_uint(v), false, false); lo = __uint_as_float(rr[0]); hi = __uint_as_float(rr[1]); }
__device__ __forceinline__ float bperm(float v, int src_lane) { return __uint_as_float((unsigned)__builtin_amdgcn_ds_bpermute(src_lane << 2, (int)__float_as_uint(v))); }
typedef unsigned long long u64;
constexpr float SSQ_ = 16777216.0f, B1Q_ = 4294967296.0f;
__device__ __forceinline__ u64 zero64_opaque() { unsigned z = 0u; asm volatile("" : "+v"(z)); return ((u64)z << 32) | z; }
__device__ __forceinline__ u64 fx_enc(float v, float q) { return (u64)(long long)(v * q); }
__device__ __forceinline__ float fx_dec(u64 v, float iq) { return (float)(long long)v * iq; }
__device__ __forceinline__ float fx_dec_ss(u64 v) { return (float)(unsigned)(v >> 32) * 256.0f + (float)(unsigned)v * (1.0f / SSQ_); }
#ifndef PROJ8
#define PROJ8 1
#endif
#ifndef P8_LO
#define P8_LO 12
#endif
#ifndef P8_HI
#define P8_HI 12
#endif
constexpr unsigned long long PROJ8_TILES = PROJ8 ? (((1ull << 36) - 1) & ~(((1ull << P8_HI) - 1) & ~((1ull << P8_LO) - 1))) : 0ull;
#ifndef EMU8
#define EMU8 0
#endif
__device__ __forceinline__ float r8f(float x, float s) { const int w = __builtin_amdgcn_cvt_pk_fp8_f32(x * s, 0.f, 0, false); return __builtin_amdgcn_cvt_f32_fp8(w, 0) * (1.0f / s); }

namespace pg8 {
#define PG8_LAS __attribute__((address_space(3)))
typedef unsigned short bf16_t;
typedef short bf16x8 __attribute__((ext_vector_type(8)));
typedef float f32x4 __attribute__((ext_vector_type(4)));
typedef unsigned u32x4 __attribute__((ext_vector_type(4)));
typedef int i32x8g __attribute__((ext_vector_type(8)));
typedef int i32x4g __attribute__((ext_vector_type(4)));
constexpr int BM = 256, BK = 64, HALF = 128, HTB = HALF * BK * 2  , STAGE_BYTES = 8 * HTB, NXCD = 8, WGM = 8;

__host__ __device__ __forceinline__ int lds_byte(int r, int c) { const int st = (r >> 4) * 2 + (c >> 5), rr = r & 15, cc = c & 31, ob = rr * 64 + cc * 2; return st * 1024 + (ob ^ (((ob >> 9) & 1) << 5)); }
__host__ __device__ __forceinline__ void stage_rc(int b, int& R, int& C) { const int st = b / 1024, sb = b % 1024, swz = sb ^ (((sb >> 9) & 1) << 5); R = (st >> 1) * 16 + swz / 64; C = (st & 1) * 32 + (swz % 64) / 2; }
__host__ __device__ __forceinline__ int perm32(int rho) { const int n = rho >> 4, i = rho & 15; return 8 * (i >> 2) + 4 * n + (i & 3); }

struct Unit { int pm, pn; };
struct Gemm { const bf16_t* A; const bf16_t* Bt; int M, N, K, lda, ldb; };

struct StaticOrder {
    int nM, nN, nwg, G, c;
    __host__ __device__ void init(int M, int N, int G_, int c_) { nM = M / BM; nN = N / BM; nwg = nM * nN; G = G_; c = c_; }
    __host__ __device__ bool next(int i, Unit& u) const {
        const long L = (long)i * G + c; if (L >= nwg) return false;
        int wgid = (int)L; { const int q = nwg / NXCD, r = nwg % NXCD, xcd = wgid % NXCD, off = wgid / NXCD; wgid = (xcd < r ? xcd * (q + 1) : r * (q + 1) + (xcd - r) * q) + off; }
        const int nig = WGM * nN, gid = wgid / nig, fm = gid * WGM, gsz = (nM - fm) < WGM ? (nM - fm) : WGM;
        u.pm = fm + ((wgid % nig) % gsz); u.pn = (wgid % nig) / gsz; return true;
    }
    __device__ __forceinline__ void a_ready(const Unit&) const {}
    __device__ __forceinline__ void done(const Unit&) const {}
};
template <int SPLIT, int SKIP> struct SubsetOrder : StaticOrder {
    __host__ __device__ bool next(int i, Unit& u) const { if (!StaticOrder::next(i, u)) return false; if (u.pn >= SPLIT) u.pn += SKIP; return true; }
};

__device__ __forceinline__ unsigned cvt_pk_bf16(float lo, float hi) { unsigned r; asm volatile("v_cvt_pk_bf16_f32 %0, %1, %2" : "=v"(r) : "v"(lo), "v"(hi)); return r; }
__device__ __forceinline__ float sigm(float x) { return __builtin_amdgcn_rcpf(1.0f + __expf(-x)); }
__device__ __forceinline__ float bflo(unsigned w) { return __uint_as_float(w << 16); }
__device__ __forceinline__ float bfhi(unsigned w) { return __uint_as_float(w & 0xffff0000u); }
__device__ __forceinline__ u32x4 pack8(const f32x4 v0, const f32x4 v1) { u32x4 w; w.x = cvt_pk_bf16(v0[0], v0[1]); w.y = cvt_pk_bf16(v0[2], v0[3]); w.z = cvt_pk_bf16(v1[0], v1[1]); w.w = cvt_pk_bf16(v1[2], v1[3]); return w; }

struct EpiProj {
    static constexpr bool PERM = true, AFTER_DRAIN = false, MIDK = false;
    unsigned char* ws; const float *qg, *kg;
    __device__ __forceinline__ void operator()(const f32x4 (&acc)[2][2][4][2], const Unit& u, int wr, int wc, int fr_in, int fq_in) const {
        int fr = fr_in, fq = fq_in; asm volatile("" : "+v"(fr), "+v"(fq));
        const int pn = u.pn; const int row0 = u.pm * BM + wr * 64 + fr;
        if (pn < 8) {
            const bool isq = pn < 4; const float* g = isq ? qg : kg; const float sc = isq ? C2Q_ : 1.0f;
            f32x4 gv[2][2];
#pragma unroll
            for (int bj = 0; bj < 2; ++bj)
#pragma unroll
                for (int n = 0; n < 2; ++n) gv[bj][n] = *(const f32x4*)(g + 32 * bj + 8 * fq + 4 * n);
            bf16_t* qbase = (bf16_t*)(ws + EP_Q) + (pn & 3) * 256 + 64 * wc + 8 * fq;
            unsigned char* kbase = ws + EP_K + (pn & 3) * 256 + 64 * wc + (fq & 1) * 32 + (fq >> 1) * 8;
#pragma unroll
            for (int ai = 0; ai < 2; ++ai)
#pragma unroll
                for (int m = 0; m < 4; ++m) {
                    float ss = 0.f;
#pragma unroll
                    for (int bj = 0; bj < 2; ++bj)
#pragma unroll
                        for (int n = 0; n < 2; ++n) { const f32x4 x = acc[ai][bj][m][n]; ss += (x[0] * x[0] + x[1] * x[1]) + (x[2] * x[2] + x[3] * x[3]); }
                    ss += swz_xor<16>(ss); { float lo_, hi_; halves(ss, lo_, hi_); ss = lo_ + hi_; }
                    const float r = sc / sqrtf(ss * (1.0f / 64.0f) + EPS_);
                    const size_t row = (size_t)(row0 + ai * HALF + m * 16);
#pragma unroll
                    for (int bj = 0; bj < 2; ++bj) { const f32x4 v0 = acc[ai][bj][m][0] * r * gv[bj][0], v1 = acc[ai][bj][m][1] * r * gv[bj][1];
                        if (isq) *(u32x4*)(qbase + row * 1024 + 32 * bj) = pack8(v0, v1);
                        else { int lo = 0, hi4 = 0; lo = __builtin_amdgcn_cvt_pk_fp8_f32(v0[0], v0[1], lo, false); lo = __builtin_amdgcn_cvt_pk_fp8_f32(v0[2], v0[3], lo, true);
                            hi4 = __builtin_amdgcn_cvt_pk_fp8_f32(v1[0], v1[1], hi4, false); hi4 = __builtin_amdgcn_cvt_pk_fp8_f32(v1[2], v1[3], hi4, true);
                            typedef int i32x2 __attribute__((ext_vector_type(2))); *(i32x2*)(kbase + row * 1024 + 16 * bj) = (i32x2){lo, hi4}; } }
                }
        } else if (pn < 12) {
            const int a = (fr >> 2) & 3, j = fr & 3;
            const unsigned selj = 0x0c0c0000u | ((4u + (unsigned)j) << 8) | (unsigned)j;
            unsigned char* vb = ws + EP_V8T + ((size_t)(2 * (pn - 8)) * 256 + (size_t)(u.pm * 4 + wr)) * 8192 + (size_t)(wc * 32 + 8 * fq + j) * 64 + (a & 1) * 32 + (a >> 1) * 4;
#pragma unroll
            for (int ai = 0; ai < 2; ++ai)
#pragma unroll
                for (int m = 0; m < 4; ++m)
#pragma unroll
                    for (int bj = 0; bj < 2; ++bj)
#pragma unroll
                        for (int n = 0; n < 2; ++n) { const f32x4 x = acc[ai][bj][m][n];
                            int w = __builtin_amdgcn_cvt_pk_fp8_f32(x[0], x[1], 0, false); w = __builtin_amdgcn_cvt_pk_fp8_f32(x[2], x[3], w, true);
                            const int l0 = __builtin_amdgcn_mov_dpp(w, 0x00, 0xf, 0xf, true), l1 = __builtin_amdgcn_mov_dpp(w, 0x55, 0xf, 0xf, true), l2 = __builtin_amdgcn_mov_dpp(w, 0xaa, 0xf, 0xf, true), l3 = __builtin_amdgcn_mov_dpp(w, 0xff, 0xf, 0xf, true);
                            const unsigned t01 = __builtin_amdgcn_perm((unsigned)l1, (unsigned)l0, selj), t23 = __builtin_amdgcn_perm((unsigned)l3, (unsigned)l2, selj);
                            const unsigned tt = __builtin_amdgcn_perm(t23, t01, 0x05040100u);
                            *(unsigned*)(vb + ((size_t)bj * 256 + (size_t)ai * 2) * 8192 + (size_t)(4 * n) * 64 + (m >> 1) * 16 + (m & 1) * 8) = tt; }
        } else {
            bf16_t* base; int ldc, c0; bool sg;
            if (pn < 20) { base = (bf16_t*)(ws + EP_MQKR); ldc = 2048; c0 = (pn - 12) * 256; sg = false; }
            else if (pn < 24) { base = (bf16_t*)(ws + EP_MV); ldc = 1024; c0 = (pn - 20) * 256; sg = false; }
            else if (pn < 28) { base = (bf16_t*)(ws + EP_MO); ldc = 1024; c0 = (pn - 24) * 256; sg = true; }
            else { base = (bf16_t*)(ws + EP_GAM); ldc = 2048; c0 = (pn - 28) * 256; sg = true; }
            const int col0 = c0 + wc * 32 + 8 * fq;
#pragma unroll
            for (int ai = 0; ai < 2; ++ai)
#pragma unroll
                for (int m = 0; m < 4; ++m) { bf16_t* rowp = base + (size_t)(row0 + ai * HALF + m * 16) * ldc + col0;
#pragma unroll
                    for (int bj = 0; bj < 2; ++bj) { f32x4 v0 = acc[ai][bj][m][0], v1 = acc[ai][bj][m][1];
                        if (sg) {
#pragma unroll
                            for (int i = 0; i < 4; ++i) { v0[i] = sigm(v0[i]); v1[i] = sigm(v1[i]); } }
                        *(u32x4*)(rowp + bj * HALF) = pack8(v0, v1); } }
        }
    }
};
struct EpiRelu2 {
    static constexpr bool PERM = true, AFTER_DRAIN = false, MIDK = false;
    bf16_t* O; int ldc; const u64* SS; const float* b1;
    __device__ __forceinline__ void operator()(const f32x4 (&acc)[2][2][4][2], const Unit& u, int wr, int wc, int fr, int fq) const {
        const int row0 = u.pm * BM + wr * 64 + fr, col0 = u.pn * BM + wc * 32 + 8 * fq;
        f32x4 bv[2][2];
#pragma unroll
        for (int bj = 0; bj < 2; ++bj)
#pragma unroll
            for (int n = 0; n < 2; ++n) bv[bj][n] = *(const f32x4*)(b1 + col0 + bj * HALF + 4 * n);
#pragma unroll
        for (int ai = 0; ai < 2; ++ai)
#pragma unroll
            for (int m = 0; m < 4; ++m) { const int row = row0 + ai * HALF + m * 16; const float r = __builtin_amdgcn_rsqf(fx_dec_ss(SS[row]) * (1.0f / 1024.0f) + EPS_);
                bf16_t* rowp = O + (size_t)row * ldc + col0;
#pragma unroll
                for (int bj = 0; bj < 2; ++bj) { f32x4 v0 = acc[ai][bj][m][0] * r + bv[bj][0], v1 = acc[ai][bj][m][1] * r + bv[bj][1];
#pragma unroll
                    for (int i = 0; i < 4; ++i) { const float a = fmaxf(v0[i], 0.f), b = fmaxf(v1[i], 0.f); v0[i] = a * a; v1[i] = b * b; if (EMU8 & 4) { v0[i] = r8f(v0[i], 1.f); v1[i] = r8f(v1[i], 1.f); } }
                    *(u32x4*)(rowp + bj * HALF) = pack8(v0, v1); } }
    }
};
struct EpiMerge {
    static constexpr bool PERM = true, AFTER_DRAIN = false, MIDK = true;
    bf16_t* O; int ldc; const bf16_t* G; int ldg;
    static __device__ __forceinline__ float g2c(float g) { return fmaxf(g, 9.094947e-13f); }
    __device__ __forceinline__ void mid(f32x4 (&acc)[2][2][4][2], const Unit& u, int wr, int wc, int fr, int fq) const {
        const int row0 = u.pm * BM + wr * 64 + fr, col0 = u.pn * BM + wc * 32 + 8 * fq;
#pragma unroll
        for (int g = 0; g < 8; ++g) { const int ai = g >> 2, m = g & 3; const size_t r = (size_t)(row0 + ai * HALF + m * 16);
#pragma unroll
            for (int bj = 0; bj < 2; ++bj) { const u32x4 q1 = *(const u32x4*)(G + r * ldg + col0 + bj * HALF), q2 = *(const u32x4*)(G + r * ldg + 1024 + col0 + bj * HALF);
                f32x4& v0 = acc[ai][bj][m][0]; f32x4& v1 = acc[ai][bj][m][1];
                v0[0] *= bflo(q1.x) * __builtin_amdgcn_rcpf(g2c(bflo(q2.x))); v0[1] *= bfhi(q1.x) * __builtin_amdgcn_rcpf(g2c(bfhi(q2.x))); v0[2] *= bflo(q1.y) * __builtin_amdgcn_rcpf(g2c(bflo(q2.y))); v0[3] *= bfhi(q1.y) * __builtin_amdgcn_rcpf(g2c(bfhi(q2.y)));
                v1[0] *= bflo(q1.z) * __builtin_amdgcn_rcpf(g2c(bflo(q2.z))); v1[1] *= bfhi(q1.z) * __builtin_amdgcn_rcpf(g2c(bfhi(q2.z))); v1[2] *= bflo(q1.w) * __builtin_amdgcn_rcpf(g2c(bflo(q2.w))); v1[3] *= bfhi(q1.w) * __builtin_amdgcn_rcpf(g2c(bfhi(q2.w))); } }
    }
    __device__ __forceinline__ void operator()(const f32x4 (&acc)[2][2][4][2], const Unit& u, int wr, int wc, int fr, int fq) const {
        const int row0 = u.pm * BM + wr * 64 + fr, col0 = u.pn * BM + wc * 32 + 8 * fq;
        u32x4 gw[2][2];
#define EG_LOAD(g_, b_) do { const size_t r_ = (size_t)(row0 + ((g_) >> 2) * HALF + ((g_) & 3) * 16); _Pragma("unroll") for (int bj = 0; bj < 2; ++bj) gw[b_][bj] = *(const u32x4*)(G + r_ * ldg + 1024 + col0 + bj * HALF); } while (0)
        EG_LOAD(0, 0);
#pragma unroll
        for (int g = 0; g < 8; ++g) { const int ai = g >> 2, m = g & 3, b = g & 1; const size_t r = (size_t)(row0 + ai * HALF + m * 16);
            if (g + 1 < 8) EG_LOAD(g + 1, (g + 1) & 1);
#pragma unroll
            for (int bj = 0; bj < 2; ++bj) { f32x4 v0 = acc[ai][bj][m][0], v1 = acc[ai][bj][m][1]; const u32x4 q = gw[b][bj];
                v0[0] *= g2c(bflo(q.x)); v0[1] *= g2c(bfhi(q.x)); v0[2] *= g2c(bflo(q.y)); v0[3] *= g2c(bfhi(q.y)); v1[0] *= g2c(bflo(q.z)); v1[1] *= g2c(bfhi(q.z)); v1[2] *= g2c(bflo(q.w)); v1[3] *= g2c(bfhi(q.w));
                *(u32x4*)(O + r * ldc + col0 + bj * HALF) = pack8(v0, v1); } }
#undef EG_LOAD
    }
};
template <bool STAT> struct EpiResid {
    static constexpr bool PERM = false, AFTER_DRAIN = false, MIDK = false;
    const float* xin; float* out; int ldc; const float* gate; bf16_t* XB; u64* SS;
    __device__ __forceinline__ void operator()(const f32x4 (&acc)[2][2][4][2], const Unit& u, int wr, int wc, int fr, int fq) const {
        const int row0 = u.pm * BM + wr * 64 + fr, col0 = u.pn * BM + wc * 32 + 4 * fq;
        f32x4 gv[2][2];
#pragma unroll
        for (int bj = 0; bj < 2; ++bj)
#pragma unroll
            for (int n = 0; n < 2; ++n) gv[bj][n] = *(const f32x4*)(gate + col0 + bj * HALF + n * 16);
        f32x4 xa[2][2][2];
#define ER_LOAD(g_, b_) do { const size_t o_ = (size_t)(row0 + ((g_) >> 2) * HALF + ((g_) & 3) * 16) * ldc + col0; _Pragma("unroll") for (int bj = 0; bj < 2; ++bj) _Pragma("unroll") for (int n = 0; n < 2; ++n) xa[b_][bj][n] = *(const f32x4*)(xin + o_ + bj * HALF + n * 16); } while (0)
        ER_LOAD(0, 0);
#pragma unroll
        for (int g = 0; g < 8; ++g) { const int ai = g >> 2, m = g & 3, b = g & 1; const int row = row0 + ai * HALF + m * 16; const size_t off = (size_t)row * ldc + col0; float ss = 0.f;
            if (g + 1 < 8) ER_LOAD(g + 1, (g + 1) & 1);
#pragma unroll
            for (int bj = 0; bj < 2; ++bj)
#pragma unroll
                for (int n = 0; n < 2; ++n) { const f32x4 y = xa[b][bj][n] + gv[bj][n] * acc[ai][bj][m][n];
                    *(f32x4*)(out + off + bj * HALF + n * 16) = y;
                    if (STAT) { ss += (y[0] * y[0] + y[1] * y[1]) + (y[2] * y[2] + y[3] * y[3]);
                        typedef unsigned u32x2 __attribute__((ext_vector_type(2))); u32x2 w; f32x4 yq = y; if (EMU8 & 2) { yq[0] = r8f(y[0], 1.f); yq[1] = r8f(y[1], 1.f); yq[2] = r8f(y[2], 1.f); yq[3] = r8f(y[3], 1.f); } w.x = cvt_pk_bf16(yq[0], yq[1]); w.y = cvt_pk_bf16(yq[2], yq[3]); *(u32x2*)(XB + off + bj * HALF + n * 16) = w; } }
            if (STAT) { ss += swz_xor<16>(ss); float lo_, hi_; halves(ss, lo_, hi_); ss = lo_ + hi_; if (fq == 0) atomicAdd(SS + row, fx_enc(ss, SSQ_)); } }
#undef ER_LOAD
    }
};

template <class Epi, class Sched, bool ALIGN_EPI = false, bool SP2 = false, bool F8 = false>
__device__ __forceinline__ void gemm_phase(PG8_LAS unsigned char* lds, const Gemm g, const Sched& S, const Epi& E, const int wid_in) {
    const int lane = lane_id_opaque(), wid = wid_in, tid = wid * 64 + lane;
    const int wr = wid >> 2, wc = wid & 3, fr = lane & 15, fq = lane >> 4;
    const int K = g.K, nt = K / BK;
    unsigned voffA, voffB;
    { int R, C; stage_rc(tid * 16, R, C); const int Rb = Epi::PERM ? ((R & ~31) + perm32(R & 31)) : R;
      voffA = (unsigned)(R * g.lda + C) * 2u; voffB = (unsigned)(Rb * g.ldb + C) * 2u; }
    const size_t d64A = (size_t)64 * g.lda * 2, d64B = (size_t)64 * g.ldb * 2;
    const size_t kstep = (size_t)(BK * 2);
    const size_t hstepA = (size_t)HALF * g.lda * 2, hstepB = (size_t)HALF * g.ldb * 2;
    const size_t tstepA = 2 * hstepA, tstepB = 2 * hstepB;
    const unsigned ldsw = (unsigned)wid * 1024u;
    const int aoff = lds_byte(wr * 64 + fr, fq * 8), boff = lds_byte(wc * 32 + fr, fq * 8);
#define PG8_SA(b, h) (((b) * 2 + (h)) * HTB)
#define PG8_SB(b, h) ((4 + (b) * 2 + (h)) * HTB)
#define PG8_STAGE(bufoff, gbase, voff) do { \
        __builtin_amdgcn_global_load_lds((const unsigned*)((const char*)(gbase) + (voff)), (PG8_LAS unsigned*)(lds + (bufoff) + ldsw), 16, 0, 0); \
        __builtin_amdgcn_global_load_lds((const unsigned*)((const char*)(gbase) + PG8_D64(voff) + (voff)), (PG8_LAS unsigned*)(lds + (bufoff) + ldsw + 8192), 16, 0, 0); } while (0)
#define PG8_D64(voff) PG8_D64_##voff
#define PG8_D64_voffA d64A
#define PG8_D64_voffB d64B
#define PG8_LD32(p) __builtin_shufflevector(*(const PG8_LAS i32x4g*)(p), *(const PG8_LAS i32x4g*)((p) + 1024), 0, 1, 2, 3, 4, 5, 6, 7)
#define PG8_LO(v) __builtin_bit_cast(bf16x8, __builtin_shufflevector(v, v, 0, 1, 2, 3))
#define PG8_HI(v) __builtin_bit_cast(bf16x8, __builtin_shufflevector(v, v, 4, 5, 6, 7))
#define PG8_LDA(dst, b, h) do { _Pragma("unroll") for (int m = 0; m < 4; ++m) dst[m] = PG8_LD32(lds + PG8_SA(b, h) + aoff + m * 2048); } while (0)
#define PG8_LDB(dst, b, h) do { _Pragma("unroll") for (int n = 0; n < 2; ++n) dst[n] = PG8_LD32(lds + PG8_SB(b, h) + boff + n * 2048); } while (0)
#define PG8_MMA(ai, bj, At, Bt) do { __builtin_amdgcn_s_setprio(1); _Pragma("unroll") for (int m = 0; m < 4; ++m) _Pragma("unroll") for (int n = 0; n < 2; ++n) { \
        if constexpr (F8) asm volatile("v_mfma_scale_f32_16x16x128_f8f6f4 %0, %1, %2, %0, %3, %3 op_sel_hi:[0,0,0]" : "+v"(acc[ai][bj][m][n]) : "v"(Bt[n]), "v"(At[m]), "v"(sc8)); \
        else { acc[ai][bj][m][n] = __builtin_amdgcn_mfma_f32_16x16x32_bf16(PG8_LO(Bt[n]), PG8_LO(At[m]), acc[ai][bj][m][n], 0, 0, 0); \
               acc[ai][bj][m][n] = __builtin_amdgcn_mfma_f32_16x16x32_bf16(PG8_HI(Bt[n]), PG8_HI(At[m]), acc[ai][bj][m][n], 0, 0, 0); } } __builtin_amdgcn_s_setprio(0); } while (0)
#define PG8_WAIT_V(n) asm volatile("s_waitcnt vmcnt(" #n ")" ::: "memory")
#define PG8_WAIT_L(n) asm volatile("s_waitcnt lgkmcnt(" #n ")" ::: "memory")
#define PG8_BAR __builtin_amdgcn_s_barrier()
#define PG8_SCHED __builtin_amdgcn_sched_barrier(0)
    Unit cur, nxt; int ui = 0;
    if (!S.next(0, cur)) return;
    f32x4 acc[2][2][4][2];
#pragma unroll
    for (int a = 0; a < 2; ++a)
#pragma unroll
        for (int b = 0; b < 2; ++b)
#pragma unroll
            for (int m = 0; m < 4; ++m)
#pragma unroll
                for (int n = 0; n < 2; ++n) acc[a][b][m][n] = (f32x4){0.f, 0.f, 0.f, 0.f};
    i32x8g At[4], B0[2], B1[2];
    int sc8 = 0x7c; asm volatile("" : "+v"(sc8));
    const char* cA = (const char*)g.A + (size_t)cur.pm * tstepA; const char* cB = (const char*)g.Bt + (size_t)cur.pn * tstepB;
    S.a_ready(cur);
    if constexpr (SP2) {
        PG8_STAGE(PG8_SB(0, 0), cB, voffB); PG8_STAGE(PG8_SB(0, 1), cB + hstepB, voffB); PG8_STAGE(PG8_SA(0, 0), cA, voffA); PG8_STAGE(PG8_SA(0, 1), cA + hstepA, voffA);
        PG8_STAGE(PG8_SB(1, 0), cB + kstep, voffB); PG8_STAGE(PG8_SA(1, 0), cA + kstep, voffA); PG8_STAGE(PG8_SB(1, 1), cB + hstepB + kstep, voffB);
        if (wr == 1) PG8_BAR;
        PG8_WAIT_V(8); PG8_BAR;
        PG8_WAIT_V(6); PG8_BAR;
    } else {
        PG8_STAGE(PG8_SB(0, 0), cB, voffB); PG8_STAGE(PG8_SA(0, 0), cA, voffA); PG8_STAGE(PG8_SB(0, 1), cB + hstepB, voffB); PG8_STAGE(PG8_SA(0, 1), cA + hstepA, voffA);
        if (wr == 1) PG8_BAR;
        PG8_WAIT_V(4); PG8_BAR;
        PG8_STAGE(PG8_SB(1, 0), cB + kstep, voffB); PG8_STAGE(PG8_SA(1, 0), cA + kstep, voffA); PG8_STAGE(PG8_SB(1, 1), cB + hstepB + kstep, voffB);
        PG8_WAIT_V(6); PG8_BAR;
    }
    for (;;) {
        const bool has_next = S.next(ui + 1, nxt);
        const char* nA = has_next ? (const char*)g.A + (size_t)nxt.pm * tstepA : cA; const char* nB = has_next ? (const char*)g.Bt + (size_t)nxt.pn * tstepB : cB;
#pragma unroll 1
        for (int t = 0; t < nt; t += 2) {
            if constexpr (Epi::MIDK) { if (t == nt / 2) { const int lm = lane_id_opaque(); E.mid(acc, cur, wr, wc, lm & 15, lm >> 4); } }
            const bool last = (t == nt - 2);
            const char* a1 = cA + (size_t)(t + 1) * kstep;
            const char* a2 = last ? nA : cA + (size_t)(t + 2) * kstep; const char* b2 = last ? nB : cB + (size_t)(t + 2) * kstep;
            const char* a3 = a2 + kstep; const char* b3 = b2 + kstep;
            if (last && has_next) S.a_ready(nxt);
            if constexpr (SP2) {
            PG8_LDB(B0, 0, 0); PG8_LDB(B1, 0, 1); PG8_SCHED; PG8_LDA(At, 0, 0); PG8_STAGE(PG8_SA(1, 1), a1 + hstepA, voffA);
            PG8_WAIT_V(8); PG8_WAIT_L(0); PG8_BAR; PG8_MMA(0, 0, At, B0); PG8_MMA(0, 1, At, B1); PG8_BAR; PG8_SCHED;
            PG8_LDA(At, 0, 1); PG8_STAGE(PG8_SB(0, 0), b2, voffB); PG8_STAGE(PG8_SB(0, 1), b2 + hstepB, voffB); PG8_STAGE(PG8_SA(0, 0), a2, voffA);
            PG8_WAIT_V(8); PG8_WAIT_L(0); PG8_BAR; PG8_MMA(1, 0, At, B0); PG8_MMA(1, 1, At, B1); PG8_BAR; PG8_SCHED;
            PG8_LDB(B0, 1, 0); PG8_LDB(B1, 1, 1); PG8_SCHED; PG8_LDA(At, 1, 0); PG8_STAGE(PG8_SA(0, 1), a2 + hstepA, voffA);
            PG8_WAIT_V(8); PG8_WAIT_L(0); PG8_BAR; PG8_MMA(0, 0, At, B0); PG8_MMA(0, 1, At, B1); PG8_BAR; PG8_SCHED;
            PG8_LDA(At, 1, 1); PG8_STAGE(PG8_SB(1, 0), b3, voffB); PG8_STAGE(PG8_SB(1, 1), b3 + hstepB, voffB); PG8_STAGE(PG8_SA(1, 0), a3, voffA);
            PG8_WAIT_V(8); PG8_WAIT_L(0); PG8_BAR; PG8_MMA(1, 0, At, B0); PG8_MMA(1, 1, At, B1); PG8_BAR; PG8_SCHED;
            } else {
            PG8_LDB(B0, 0, 0); PG8_SCHED; PG8_LDA(At, 0, 0); PG8_STAGE(PG8_SA(1, 1), a1 + hstepA, voffA);
            PG8_WAIT_L(8); PG8_BAR; PG8_WAIT_L(0); PG8_MMA(0, 0, At, B0); PG8_BAR; PG8_SCHED;
            PG8_LDB(B1, 0, 1); PG8_STAGE(PG8_SB(0, 0), b2, voffB);
            PG8_BAR; PG8_WAIT_L(0); PG8_MMA(0, 1, At, B1); PG8_BAR;
            PG8_LDA(At, 0, 1); PG8_STAGE(PG8_SA(0, 0), a2, voffA);
            PG8_BAR; PG8_WAIT_L(0); PG8_MMA(1, 0, At, B0); PG8_BAR; PG8_SCHED;
            PG8_STAGE(PG8_SB(0, 1), b2 + hstepB, voffB);
            PG8_WAIT_V(6); PG8_BAR; PG8_MMA(1, 1, At, B1); PG8_BAR;
            PG8_LDB(B0, 1, 0); PG8_SCHED; PG8_LDA(At, 1, 0); PG8_STAGE(PG8_SA(0, 1), a2 + hstepA, voffA);
            PG8_WAIT_L(8); PG8_BAR; PG8_WAIT_L(0); PG8_MMA(0, 0, At, B0); PG8_BAR; PG8_SCHED;
            PG8_LDB(B1, 1, 1); PG8_STAGE(PG8_SB(1, 0), b3, voffB);
            PG8_BAR; PG8_WAIT_L(0); PG8_MMA(0, 1, At, B1); PG8_BAR;
            PG8_LDA(At, 1, 1); PG8_STAGE(PG8_SA(1, 0), a3, voffA);
            PG8_BAR; PG8_WAIT_L(0); PG8_MMA(1, 0, At, B0); PG8_BAR; PG8_SCHED;
            PG8_STAGE(PG8_SB(1, 1), b3 + hstepB, voffB);
            PG8_WAIT_V(6); PG8_BAR; PG8_MMA(1, 1, At, B1); PG8_BAR;
            }
        }
        if constexpr (F8) asm volatile("s_nop 15\n\ts_nop 15" ::: "memory");
        if constexpr (ALIGN_EPI) { if (wr == 0) PG8_BAR; }
        if constexpr (!Epi::AFTER_DRAIN) { const int le = lane_id_opaque(); E(acc, cur, wr, wc, le & 15, le >> 4); S.done(cur); }
        if (!has_next) break;
#pragma unroll
        for (int a = 0; a < 2; ++a)
#pragma unroll
            for (int b = 0; b < 2; ++b)
#pragma unroll
                for (int m = 0; m < 4; ++m)
#pragma unroll
                    for (int n = 0; n < 2; ++n) acc[a][b][m][n] = (f32x4){0.f, 0.f, 0.f, 0.f};
        cur = nxt; cA = nA; cB = nB; ++ui;
        if constexpr (ALIGN_EPI) { if (wr == 1) PG8_BAR; }
    }
    PG8_WAIT_V(0);
    if constexpr (!ALIGN_EPI) { if (wr == 0) PG8_BAR; }
    PG8_BAR;
    if constexpr (Epi::AFTER_DRAIN) { E.fused(acc, cur, wr, wc, fr, fq, lds, wid, lane); S.done(cur); }
#undef PG8_SA
#undef PG8_SB
#undef PG8_STAGE
#undef PG8_D64
#undef PG8_D64_voffA
#undef PG8_D64_voffB
#undef PG8_LDA
#undef PG8_LDB
#undef PG8_MMA
#undef PG8_LD32
#undef PG8_LO
#undef PG8_HI
#undef PG8_WAIT_V
#undef PG8_WAIT_L
#undef PG8_BAR
#undef PG8_SCHED
}
}

constexpr size_t MiB = 1u << 20;
constexpr size_t WS_CTL = 0, CTL_ZERO_BYTES = 64 * 1024;
constexpr size_t WS_MODP = 1 * MiB;
constexpr size_t WS_MOD = 3 * MiB;
constexpr size_t WS_TAB = 3 * MiB + 512 * 1024;
constexpr size_t WS_IG = 4 * MiB;
constexpr size_t WS_LF = WS_IG + 256 * 1024, WS_BC = WS_LF + 256 * 1024, WS_AA = WS_BC + 256 * 1024;
constexpr size_t WS_CHK = 5 * MiB;
constexpr size_t WS_BL = WS_CHK, WS_ML = WS_CHK + 4096, WS_MP = WS_CHK + 8192;
constexpr size_t WS_NU = 5 * MiB + 64 * 1024;
constexpr size_t WS_NST = WS_NU + 512 * 1024;
constexpr size_t WS_PAR = 7 * MiB;
constexpr int PAR_L = 21008, PR_NMG = 0, PR_NFG = 1024, PR_QNG = 2048, PR_KNG = 2112, PR_SUBG = 2176, PR_MHG = 2304, PR_BIG = 2560, PR_BFG = 2564, PR_CONVB = 2576, PR_CONVW = 4624, PR_GW = 12816;
constexpr size_t WS_SS = 7 * MiB + 512 * 1024;
constexpr size_t WS_B1 = 7 * MiB + 640 * 1024;
constexpr size_t WS_B1F = WS_B1 + 2 * 4096 * 8;
static_assert(WS_B1F + 4096 * 4 <= 8 * MiB, "B1F");
constexpr size_t WS_W = 8 * MiB;
constexpr size_t W_IN = 0, W_A = 18 * MiB, W_M = 20 * MiB, W_OUT = 22 * MiB, W_F1 = 24 * MiB, W_F2 = 32 * MiB;
constexpr size_t WS_XN = 48 * MiB;
constexpr size_t WS_MK = WS_XN;
constexpr size_t WS_Q = 80 * MiB, WS_K = 112 * MiB;
constexpr size_t WS_UB = WS_Q;
constexpr size_t WS_V8T = WS_K + 16 * MiB;
constexpr size_t WS_V = 144 * MiB;
constexpr size_t WS_MQ = WS_V;
constexpr size_t WS_FFU = WS_Q;
constexpr size_t WS_MQKR = 176 * MiB;
constexpr size_t WS_CST = WS_MQKR;
constexpr size_t WS_MV = 240 * MiB, WS_MO = 272 * MiB;
constexpr size_t WS_GAM = 304 * MiB;
constexpr size_t WS_YAM = 368 * MiB;
constexpr size_t WS_XB = WS_YAM;
constexpr size_t WS_W2 = 432 * MiB;
constexpr size_t WS_END = 472 * MiB;
static_assert(WS_SS + (size_t)S_ * 8 <= WS_B1 && WS_B1 + 2 * 4096 * 8 <= WS_W && WS_PAR + (size_t)DEPTH_ * PAR_L * 4 <= WS_SS && WS_NST + 512 * 1024 <= WS_PAR && WS_PAR + (size_t)DEPTH_ * PAR_L * 4 <= WS_W && WS_MODP + 16 * 24576 * 4 <= WS_MOD && WS_MOD + 24576 * 4 <= WS_TAB && WS_AA + 256 * 1024 <= WS_CHK && WS_MP + 4096 <= WS_NU, "small-region map");
static_assert(EP_Q == WS_Q && EP_K == WS_K && EP_V8T == WS_V8T && EP_V == WS_V && EP_MQKR == WS_MQKR && EP_MV == WS_MV && EP_MO == WS_MO && EP_GAM == WS_GAM, "projection epilogue offsets");

constexpr int LDS_BYTES = 147456;
constexpr int MISC_OFF = LDS_BYTES - 256;

#define GAS __attribute__((address_space(1)))
#define LAS __attribute__((address_space(3)))
typedef unsigned short bf16;
typedef unsigned v4u __attribute__((ext_vector_type(4)));
typedef unsigned v2u __attribute__((ext_vector_type(2)));
typedef float f32x4 __attribute__((ext_vector_type(4)));
typedef float f32x16 __attribute__((ext_vector_type(16)));
typedef short bf16x8 __attribute__((ext_vector_type(8)));
typedef short s16x4 __attribute__((ext_vector_type(4)));
typedef GAS unsigned gu32;
#define RLX_AGENT __ATOMIC_RELAXED, __HIP_MEMORY_SCOPE_AGENT
#define LDS_WAIT() asm volatile("s_waitcnt lgkmcnt(0)" ::: "memory")
#define VM_WAIT() asm volatile("s_waitcnt vmcnt(0)" ::: "memory")
__device__ __forceinline__ unsigned pk2(float lo, float hi) { return pg8::cvt_pk_bf16(lo, hi); }
__device__ __forceinline__ float bf2f(bf16 b) { return __uint_as_float((unsigned)b << 16); }
__device__ __forceinline__ bf16 f2bf(float f) { return (bf16)(pg8::cvt_pk_bf16(f, 0.f) & 0xffffu); }
__device__ __forceinline__ int crow(int r, int hi) { return (r & 3) + 8 * (r >> 2) + 4 * hi; }
__device__ __forceinline__ float half_sum(float v) {
    v += swz_xor<1>(v); v += swz_xor<2>(v); v += swz_xor<4>(v); v += swz_xor<8>(v); v += swz_xor<16>(v); return v;
}
__device__ __forceinline__ float half_max(float v) {
    v = fmaxf(v, swz_xor<1>(v)); v = fmaxf(v, swz_xor<2>(v)); v = fmaxf(v, swz_xor<4>(v)); v = fmaxf(v, swz_xor<8>(v)); v = fmaxf(v, swz_xor<16>(v)); return v;
}
__device__ __forceinline__ float swap_add(float v) { float lo, hi; halves(v, lo, hi); return lo + hi; }
__device__ __forceinline__ float wave_sum(float v) { return swap_add(half_sum(v)); }
__device__ __forceinline__ float wave_max(float v) { float lo, hi; halves(half_max(v), lo, hi); return fmaxf(lo, hi); }
typedef short v4i16_t __attribute__((ext_vector_type(4)));
__device__ __forceinline__ s16x4 vtr(const LAS unsigned char* p) { return __builtin_bit_cast(s16x4, __builtin_amdgcn_ds_read_tr16_b64_v4i16((LAS v4i16_t*)p)); }
__device__ __forceinline__ bf16x8 tr8(const LAS unsigned char* p, int second_off) {
    const s16x4 lo = vtr(p), hi = vtr(p + second_off);
    return (bf16x8){lo[0], lo[1], lo[2], lo[3], hi[0], hi[1], hi[2], hi[3]};
}
#define MFMA32(a, b, c) __builtin_amdgcn_mfma_f32_32x32x16_bf16(a, b, c, 0, 0, 0)

#define XB_TMO      128
#define XB_XCNT(j)  (256  + 64 * (j))
#define XB_XSUB(j)  (1280 + 64 * (j))
#define XB_XGEN(j)  (2304 + 64 * (j))
#define XB_TOP      3328
#define XB_TOPGEN   3392
#define XCD_BAR_WORDS 3456
#define XB_SPIN_CAP (1u << 18)

__device__ __forceinline__ unsigned xb_ld(unsigned* p)              { return __hip_atomic_load(p, __ATOMIC_RELAXED, __HIP_MEMORY_SCOPE_AGENT); }
__device__ __forceinline__ unsigned xb_add(unsigned* p, unsigned v) { return __hip_atomic_fetch_add(p, v, __ATOMIC_RELAXED, __HIP_MEMORY_SCOPE_AGENT); }
__device__ __forceinline__ unsigned xb_xcc_id() { return (unsigned)__builtin_amdgcn_s_getreg((3 << 11) | 20) & 0xFu; }
#define XB_SPIN(cond, bar) do { unsigned _sp = 0; while (cond) { __builtin_amdgcn_s_sleep(1); \
    if ((++_sp & 255u) == 0u) { if (xb_ld(&(bar)[XB_TMO])) break; if (_sp > XB_SPIN_CAP) { atomicAdd(&(bar)[XB_TMO], 1u); break; } } } } while (0)

struct XcdBarrier {
    unsigned* bar; unsigned x;
    volatile LAS unsigned* st;
};

__device__ __forceinline__ XcdBarrier xcd_barrier_post(unsigned* bar, volatile LAS unsigned* st) {
    XcdBarrier b; b.bar = bar; b.x = xb_xcc_id(); b.st = st;
    if (threadIdx.x == 0) (void)xb_add(&bar[XB_XCNT(b.x)], 1u);
    return b;
}
__device__ __forceinline__ void xcd_barrier_complete(unsigned* bar, unsigned x, unsigned& nloc, unsigned& nx) {
    const unsigned G = gridDim.x * gridDim.y * gridDim.z;
    unsigned sum, cnt, mine, sp = 0u;
    for (;;) {
        sum = 0u; cnt = 0u; mine = 0u;
#pragma unroll
        for (unsigned j = 0; j < 16; ++j) { const unsigned c = xb_ld(&bar[XB_XCNT(j)]); sum += c; cnt += (c > 0u) ? 1u : 0u; mine = (j == x) ? c : mine; }
        if (sum == G) break;
        __builtin_amdgcn_s_sleep(1);
        if ((++sp & 255u) == 0u) { if (xb_ld(&bar[XB_TMO])) break; if (sp > XB_SPIN_CAP) { atomicAdd(&bar[XB_TMO], 1u); break; } }
    }
    nloc = mine > 0u ? mine : 1u; nx = cnt > 0u ? cnt : 1u;
}

template <bool EXEC_ONLY = false>
__device__ __forceinline__ void xcd_barrier(const XcdBarrier& b, const bool is_thread0) {
    asm volatile("s_waitcnt vmcnt(0)" ::: "memory");
    __syncthreads();
    if (is_thread0) {
        unsigned* bar = b.bar;
        __builtin_amdgcn_s_waitcnt(0);
        unsigned nloc = b.st[0], nx = b.st[1];
        if (nloc == 0u) { xcd_barrier_complete(bar, b.x, nloc, nx); b.st[0] = nloc; b.st[1] = nx; }
        const unsigned old = xb_add(&bar[XB_XSUB(b.x)], 1u);
        const unsigned gen = old / nloc;
        if (old + 1u == (gen + 1u) * nloc) {
            if (!EXEC_ONLY) __builtin_amdgcn_fence(__ATOMIC_RELEASE, "agent");
            asm volatile("s_waitcnt vmcnt(0)" ::: "memory");
            const unsigned og = xb_add(&bar[XB_TOP], 1u);
            const unsigned tg = og / nx;
            if (og + 1u == (tg + 1u) * nx) xb_add(&bar[XB_TOPGEN], 1u);
            else XB_SPIN(xb_ld(&bar[XB_TOPGEN]) == tg, bar);
            if (!EXEC_ONLY) __builtin_amdgcn_fence(__ATOMIC_ACQUIRE, "agent");
            xb_add(&bar[XB_XGEN(b.x)], 1u);
            asm volatile("s_waitcnt vmcnt(0)" ::: "memory");
        } else {
            XB_SPIN(xb_ld(&bar[XB_XGEN(b.x)]) == gen, bar);
            if (!EXEC_ONLY) __builtin_amdgcn_fence(__ATOMIC_ACQUIRE, "agent");
            asm volatile("s_waitcnt vmcnt(0)" ::: "memory");
        }
    }
    __syncthreads();
}

struct Ctx { LAS unsigned char* lds; int tid, lane, wave, vcu, G; };

__device__ __forceinline__ void prologue_a(const Ctx& F, const float* c, const float* w_ada, float* modp) {
    const int gw = F.vcu * 8 + F.wave, NGW = F.G * 8;
    for (int it = gw; it < 96 * 16; it += NGW) {
        const int cg = it % 96, ks = it / 96; const int l = cg / 24, n0 = (cg % 24) * 256 + 4 * F.lane;
        const float* wp = w_ada + ((size_t)l * 1024 + ks * 64) * 6144 + n0;
        f32x4 a = {0.f, 0.f, 0.f, 0.f};
        const float cvl = c[ks * 64 + F.lane]; const float svl = cvl / (1.0f + __expf(-cvl));
#pragma unroll
        for (int kb = 0; kb < 2; ++kb) {
            f32x4 w[32];
#pragma unroll
            for (int k = 0; k < 32; ++k) w[k] = *(const f32x4*)(wp + (size_t)(32 * kb + k) * 6144);
#pragma unroll
            for (int k = 0; k < 32; ++k) a += __uint_as_float((unsigned)__builtin_amdgcn_readlane((int)__float_as_uint(svl), 32 * kb + k)) * w[k];
        }
        *(f32x4*)(modp + (size_t)ks * 24576 + cg * 256 + 4 * F.lane) = a;
    }
}
struct TrD { const float* W; bf16* WT; int ldw, K, k0, nsrc0, ndst0, kd, kind; float es; };
__device__ __forceinline__ void tr_load(const TrD& d, int lane, f32x4 (&r)[8]) {
#pragma unroll
    for (int i = 0; i < 8; ++i) { const int kk = 8 * i + (lane >> 3), n4 = 4 * (lane & 7); r[i] = *(const f32x4*)(d.W + (size_t)(d.k0 + kk) * d.ldw + d.nsrc0 + n4); }
}
__device__ __forceinline__ void tr_finish(const TrD& d, const f32x4 (&r)[8], LAS float* scr, int lane, const float* gs, const float* scf, const float* shf, u64* b1) {
#pragma unroll
    for (int i = 0; i < 8; ++i) { const int kk = 8 * i + (lane >> 3), n4 = 4 * (lane & 7); f32x4 wv_ = r[i];
        if (d.es > 0.f) { wv_.x = r8f(wv_.x, d.es); wv_.y = r8f(wv_.y, d.es); wv_.z = r8f(wv_.z, d.es); wv_.w = r8f(wv_.w, d.es); }
        LAS float* d_ = scr + kk * 33 + n4; d_[0] = wv_.x; d_[1] = wv_.y; d_[2] = wv_.z; d_[3] = wv_.w; }
    LDS_WAIT(); asm volatile("" ::: "memory");
    const int c = lane & 7; const int k0 = d.k0;
    if (d.kind == 1) {
#pragma unroll
        for (int j = 0; j < 4; ++j) { const int n = (lane >> 3) + 8 * j; const LAS float* s = scr + (8 * c) * 33 + n;
            int lo = __builtin_amdgcn_cvt_pk_fp8_f32(64.f * s[0 * 33], 64.f * s[1 * 33], 0, false); lo = __builtin_amdgcn_cvt_pk_fp8_f32(64.f * s[2 * 33], 64.f * s[3 * 33], lo, true);
            int hi = __builtin_amdgcn_cvt_pk_fp8_f32(64.f * s[4 * 33], 64.f * s[5 * 33], 0, false); hi = __builtin_amdgcn_cvt_pk_fp8_f32(64.f * s[6 * 33], 64.f * s[7 * 33], hi, true);
            v2u o; o.x = (unsigned)lo; o.y = (unsigned)hi;
            *(GAS v2u*)((unsigned char*)d.WT + (size_t)(d.ndst0 + n) * d.K * 2 + d.kd + k0 + 8 * c) = o; }
    } else if (d.kind == 2) {
        { const int n = lane & 31, kh = (lane >> 5) * 32; float p = 0.f;
#pragma unroll 8
          for (int kk = 0; kk < 32; ++kk) p += shf[k0 + kh + kk] * scr[(kh + kk) * 33 + n];
          atomicAdd(b1 + d.ndst0 + n, fx_enc(p, B1Q_)); }
        float sck[8];
#pragma unroll
        for (int e = 0; e < 8; ++e) sck[e] = gs[k0 + 8 * c + e] * (1.0f + scf[k0 + 8 * c + e]);
#pragma unroll
        for (int j = 0; j < 4; ++j) { const int n = (lane >> 3) + 8 * j; const LAS float* s = scr + (8 * c) * 33 + n;
            float sv_[8];
#pragma unroll
            for (int e = 0; e < 8; ++e) { sv_[e] = s[e * 33] * sck[e]; if (EMU8 & 2) sv_[e] = r8f(sv_[e], 64.f); }
            v4u o; o.x = pk2(sv_[0], sv_[1]); o.y = pk2(sv_[2], sv_[3]); o.z = pk2(sv_[4], sv_[5]); o.w = pk2(sv_[6], sv_[7]);
            *(GAS v4u*)(d.WT + (size_t)(d.ndst0 + n) * d.K + k0 + 8 * c) = o; }
    } else {
#pragma unroll
        for (int j = 0; j < 4; ++j) { const int n = (lane >> 3) + 8 * j; const LAS float* s = scr + (8 * c) * 33 + n;
            v4u o; o.x = pk2(s[0 * 33], s[1 * 33]); o.y = pk2(s[2 * 33], s[3 * 33]); o.z = pk2(s[4 * 33], s[5 * 33]); o.w = pk2(s[6 * 33], s[7 * 33]);
            *(GAS v4u*)(d.WT + (size_t)(d.ndst0 + n) * d.K + d.kd + k0 + 8 * c) = o; }
    }
    LDS_WAIT(); asm volatile("" ::: "memory");
}
__device__ __forceinline__ void prologue_b(const Ctx& F, const float* const* in, unsigned char* ws) {
    const int gt = F.vcu * 512 + F.tid;
    if (gt < 24576) { const float* mp = (const float*)(ws + WS_MODP); float s = in[3][gt];
#pragma unroll
        for (int k = 0; k < 16; ++k) s += mp[(size_t)k * 24576 + gt];
        ((float*)(ws + WS_MOD))[gt] = s; }
    if (gt >= 32768 && gt < 32768 + 1024) {
        const int i = gt - 32768, h = i >> 7, d = i & 127; const float* rel = in[13];
        int b; if (d < 16) b = d; else { const float nf = (float)d; int lg = 16 + (int)(logf(nf / 16.0f) / 2.0794415416798357f * 16.0f); b = lg < 31 ? lg : 31; }
        ((float*)(ws + WS_TAB))[i] = LOG2E_ * (rel[b * 8 + h] - rel[31 * 8 + h]); }
    if (gt >= 49152 && gt < 49152 + 4096) ((u64*)(ws + WS_B1))[gt - 49152] = zero64_opaque();
    if (gt >= 40960 && gt < 40960 + 4) {
        const int l = gt - 40960; const float* lq = in[11] + l * 256; float s01 = 0.f, s23 = 0.f;
        f32x4 a_[16], b_[16], c_[16], d_[16];
#pragma unroll
        for (int i = 0; i < 16; ++i) { a_[i] = *(const f32x4*)(lq + 4 * i); b_[i] = *(const f32x4*)(lq + 64 + 4 * i); c_[i] = *(const f32x4*)(lq + 128 + 4 * i); d_[i] = *(const f32x4*)(lq + 192 + 4 * i); }
#pragma unroll
        for (int i = 0; i < 16; ++i)
#pragma unroll
            for (int e = 0; e < 4; ++e) { s01 += a_[i][e] * b_[i][e]; s23 += c_[i][e] * d_[i][e]; }
        const float li = 0.8f - 0.6f * expf(-0.3f * (float)l);
        float* lt = (float*)(ws + WS_TAB + 4096) + l * 4; lt[0] = expf(s01) - expf(s23) + li; lt[1] = 1.0f - li; lt[2] = 0.f; lt[3] = 0.f; }
    { float* par = (float*)(ws + WS_PAR); const int NT = F.G * 512;
#define CP(off, src, n) for (int i = gt; i < DEPTH_ * (n); i += NT) { const int l_ = i / (n), j_ = i % (n); par[(size_t)l_ * PAR_L + (off) + j_] = (src)[i]; }
      CP(PR_NMG, in[4], 1024) CP(PR_NFG, in[5], 1024) CP(PR_QNG, in[9], 64) CP(PR_KNG, in[10], 64) CP(PR_SUBG, in[12], 128) CP(PR_MHG, in[16], 256)
      CP(PR_BIG, in[7], 4) CP(PR_BFG, in[8], 4) CP(PR_CONVB, in[15], 2048) CP(PR_CONVW, in[14], 8192)
#undef CP
      for (int i = gt; i < DEPTH_ * 8192; i += NT) { const int l_ = i >> 13, k_ = (i >> 3) & 1023, j_ = i & 7; par[(size_t)l_ * PAR_L + PR_GW + (i & 8191)] = in[6][((size_t)l_ * 1024 + k_) * NIN_SRC + GATE_COL + j_]; }
    }
}
__device__ __forceinline__ TrD wconv_item(int it, const float* const* in, unsigned char* wl, int l, int sel) {
    constexpr int I_IN = 16 * (NIN_ / 32), I_SQ = 16 * 32, I_F1 = 16 * 128;
    TrD d; d.W = nullptr; d.WT = nullptr; d.ldw = 0; d.K = 0; d.k0 = 0; d.nsrc0 = 0; d.ndst0 = 0; d.kd = 0; d.kind = -1; d.es = 0.f;
    int r = it;
    if (sel == 2 && (r < I_IN + 3 * I_SQ || r >= I_IN + 3 * I_SQ + I_F1)) return d;
    if (r < I_IN) { const int nb = r % (NIN_ / 32), kb = r / (NIN_ / 32); const int nd0 = nb * 32; int n = nd0;
        if (nd0 < 2048) { const int pn = nd0 >> 8, pc = nd0 & 255; n = pn * 256 + 64 * ((pc >> 5) & 3) + 32 * (pc >> 7); }
        d.W = in[6] + (size_t)l * 1024 * NIN_SRC; d.ldw = NIN_SRC; d.WT = (bf16*)(wl + W_IN); d.K = 1024; d.k0 = kb * 64; d.nsrc0 = n < GATE_COL ? n : n + 8; d.ndst0 = nd0;
        d.es = ((EMU8 & 1) || ((EMU8 & 8) && (nd0 < 2048 || nd0 >= 6144))) ? 64.f : 0.f; d.kind = (int)((PROJ8_TILES >> (nd0 >> 8)) & 1ull); return d; }
    r -= I_IN;
    if (r < 3 * I_SQ) { const int w = r / I_SQ, rr = r % I_SQ; const int nb = rr % 32, kb = rr / 32;
        d.W = in[17 + w] + (size_t)l * 1024 * 1024; d.ldw = 1024; d.k0 = kb * 64; d.nsrc0 = nb * 32; d.ndst0 = nb * 32; d.kind = 0;
        if (w < 2) { d.WT = (bf16*)(wl + W_A); d.K = 2048; d.kd = w * 1024; }
        else { d.WT = (bf16*)(wl + W_OUT); d.K = 1024; }
        return d; }
    r -= 3 * I_SQ;
    if (r < I_F1) { if (sel == 1) return d; const int nb = r % 128, kb = r / 128;
        d.W = in[20] + (size_t)l * 1024 * 4096; d.ldw = 4096; d.WT = (bf16*)(wl + W_F1); d.K = 1024; d.k0 = kb * 64; d.nsrc0 = nb * 32; d.ndst0 = nb * 32; d.kind = 2; return d; }
    r -= I_F1;
    { const int nb = r % 32, kb = r / 32;
      d.W = in[21] + (size_t)l * 4096 * 1024; d.ldw = 1024; d.WT = (bf16*)(wl + W_F2); d.K = 4096; d.k0 = kb * 64; d.nsrc0 = nb * 32; d.ndst0 = nb * 32; d.kind = 0; d.es = (EMU8 & 4) ? 128.f : 0.f; }
    return d;
}
__device__ __forceinline__ void wconv_layer(const Ctx& F, const float* const* in, unsigned char* wl, int l, int vcu0, const float* par_l, const float* mod_l, u64* b1, int sel = 0) {
    LAS float* scr = (LAS float*)(F.lds + F.wave * 16384);
    const int gw = (F.vcu - vcu0) * 8 + F.wave, NGW = (F.G - vcu0) * 8;
    constexpr int I_L = 16 * (NIN_ / 32) + 3 * 16 * 32 + 16 * 128 + 64 * 32;
    const float* gs = par_l ? par_l + PR_NFG : nullptr; const float* scf = mod_l ? mod_l + 4096 : nullptr; const float* shf = mod_l ? mod_l + 3072 : nullptr;
    int it = gw; TrD d; d.kind = -1; f32x4 r[8];
    if (it < I_L) { d = wconv_item(it, in, wl, l, sel); if (d.kind >= 0) tr_load(d, F.lane, r); }
    while (it < I_L) {
        const int itn = it + NGW; TrD dn; dn.kind = -1; f32x4 rn[8];
        if (itn < I_L) { dn = wconv_item(itn, in, wl, l, sel); if (dn.kind >= 0) tr_load(dn, F.lane, rn); }
        if (d.kind >= 0) tr_finish(d, r, scr, F.lane, gs, scf, shf, b1);
        d = dn; it = itn;
#pragma unroll
        for (int i = 0; i < 8; ++i) r[i] = rn[i];
    }
}
template <bool GATES>
__device__ __forceinline__ void norm_phase(const Ctx& F, const float* x, bf16* XN, const float* g, const float* sh, const float* sc,
                                           const float* win, const float* big, const float* bfg, float* IG, float* LF, u64* SS, u64* b1z, unsigned char* XN8 = nullptr) {
    const int gw = F.vcu * 8 + F.wave, NGW = F.G * 8; const int lane = F.lane;
    if (GATES) { const int gt = F.vcu * 512 + F.tid; if (gt < 4096) b1z[gt] = zero64_opaque(); }
    f32x4 gs[4], sv[4];
#pragma unroll
    for (int j = 0; j < 4; ++j) { const f32x4 gg = *(const f32x4*)(g + 4 * lane + 256 * j), s1 = *(const f32x4*)(sc + 4 * lane + 256 * j); gs[j] = gg * (1.0f + s1); sv[j] = *(const f32x4*)(sh + 4 * lane + 256 * j); }
    f32x4 wg[4][4][2];
    if (GATES) {
#pragma unroll
        for (int j = 0; j < 4; ++j)
#pragma unroll
            for (int i = 0; i < 4; ++i) { const float* wp = win + (size_t)(4 * lane + 256 * j + i) * 8; wg[j][i][0] = *(const f32x4*)wp; wg[j][i][1] = *(const f32x4*)(wp + 4); }
    }
    f32x4 vn[4];
    if (gw < S_) { const GAS f32x4* xr0 = (const GAS f32x4*)(x + (size_t)gw * 1024) + lane;
#pragma unroll
        for (int j = 0; j < 4; ++j) vn[j] = xr0[64 * j]; }
    for (int m = gw; m < S_; m += NGW) {
        f32x4 v[4]; float ss = 0.f;
#pragma unroll
        for (int j = 0; j < 4; ++j) v[j] = vn[j];
        if (m + NGW < S_) { const GAS f32x4* xr1 = (const GAS f32x4*)(x + (size_t)(m + NGW) * 1024) + lane;
#pragma unroll
            for (int j = 0; j < 4; ++j) vn[j] = xr1[64 * j]; }
#pragma unroll
        for (int j = 0; j < 4; ++j) ss += (v[j].x * v[j].x + v[j].y * v[j].y) + (v[j].z * v[j].z + v[j].w * v[j].w);
        const float r = 1.0f / sqrtf(wave_sum(ss) * (1.0f / 1024.0f) + EPS_);
        GAS v2u* o8 = (GAS v2u*)(XN + (size_t)m * 1024) + lane;
#pragma unroll
        for (int j = 0; j < 4; ++j) { v[j] = v[j] * r * gs[j] + sv[j]; f32x4 vq = v[j]; if (EMU8 & 1) { vq.x = r8f(vq.x, 1.f); vq.y = r8f(vq.y, 1.f); vq.z = r8f(vq.z, 1.f); vq.w = r8f(vq.w, 1.f); } v2u w; w.x = pk2(vq.x, vq.y); w.y = pk2(vq.z, vq.w); if (!(PROJ8 && GATES) || P8_HI > P8_LO) o8[64 * j] = w;
            if (PROJ8 && GATES) { int w8 = __builtin_amdgcn_cvt_pk_fp8_f32(v[j].x, v[j].y, 0, false); w8 = __builtin_amdgcn_cvt_pk_fp8_f32(v[j].z, v[j].w, w8, true);
                *(GAS int*)(XN8 + (size_t)m * 2048 + 4 * lane + 256 * j) = w8; } }
        if (GATES) {
            f32x4 d0 = {0.f, 0.f, 0.f, 0.f}, d1 = {0.f, 0.f, 0.f, 0.f};
#pragma unroll
            for (int j = 0; j < 4; ++j)
#pragma unroll
                for (int i = 0; i < 4; ++i) { d0 += v[j][i] * wg[j][i][0]; d1 += v[j][i] * wg[j][i][1]; }
#pragma unroll
            for (int q = 0; q < 4; ++q) { d0[q] = wave_sum(d0[q]); d1[q] = wave_sum(d1[q]); }
            if (lane == 0) SS[m] = zero64_opaque();
            if (lane < 4) {
                const float dq0 = lane == 0 ? d0[0] : (lane == 1 ? d0[1] : (lane == 2 ? d0[2] : d0[3])), dq1 = lane == 0 ? d1[0] : (lane == 1 ? d1[1] : (lane == 2 ? d1[2] : d1[3]));
                IG[(size_t)lane * S_ + m] = dq0 + big[lane]; const float z = dq1 + bfg[lane]; LF[(size_t)lane * S_ + m] = fminf(z, 0.f) - log1pf(__expf(-fabsf(z)));
            }
        }
    }
}

namespace att {
constexpr int QS_OFF = 73728;
constexpr int KSL8 = 8192, VSL = 8192, VRING = 4 * KSL8, BT_OFF = VRING + 4 * VSL, WS_OFF = BT_OFF + 2304;
__device__ __forceinline__ void glds(const void* g, LAS unsigned char* l) { __builtin_amdgcn_global_load_lds((const unsigned*)g, (LAS unsigned*)l, 16, 0, 0); }
#define SB0() __builtin_amdgcn_sched_barrier(0)
typedef float f32x2_t __attribute__((ext_vector_type(2))); typedef __bf16 bf16x2_t __attribute__((ext_vector_type(2)));
__device__ __forceinline__ unsigned cvtpk_s(float lo, float hi) { f32x2_t v = {lo, hi}; bf16x2_t b = __builtin_convertvector(v, bf16x2_t); return __builtin_bit_cast(unsigned, b); }
#define EXP2F(x) __builtin_amdgcn_exp2f(x)
#define PIN(x) asm volatile("" : "+v"(x))
template <bool NEAR>
__device__ __forceinline__ void ex4(const f32x16& P, int b, unsigned& w0, unsigned& w1, float& sacc, const LAS float* tb, int o) {
    float x0 = P[b], x1 = P[b + 1], x2 = P[b + 2], x3 = P[b + 3];
    if (NEAR) { x0 += tb[o]; x1 += tb[o + 1]; x2 += tb[o + 2]; x3 += tb[o + 3]; }
    x0 = EXP2F(x0); x1 = EXP2F(x1); x2 = EXP2F(x2); x3 = EXP2F(x3);
    w0 = cvtpk_s(x0, x1); w1 = cvtpk_s(x2, x3); sacc += (x0 + x1) + (x2 + x3);
    PIN(w0); PIN(w1); PIN(sacc);
}
#define DSR128(dst, addr, off) asm volatile("ds_read_b128 %0, %1 offset:" #off : "=v"(dst) : "v"(addr))
#define K8ADDR(kslot) ((kslot) + lofsK)
#define V8ADDR(vslot) ((vslot) + lofsV)
typedef int i32x8 __attribute__((ext_vector_type(8)));
typedef int i32x4 __attribute__((ext_vector_type(4)));
#define LD8(p, o0, o1) __builtin_shufflevector(*(const LAS i32x4*)((p) + (o0)), *(const LAS i32x4*)((p) + (o1)), 0, 1, 2, 3, 4, 5, 6, 7)
#define I8(a, c) ((i32x8){(int)(a).x, (int)(a).y, (int)(a).z, (int)(a).w, (int)(c).x, (int)(c).y, (int)(c).z, (int)(c).w})
#define P8(p, o) ((i32x8){p[o], p[o + 1], p[o + 2], p[o + 3], p[o + 4], p[o + 5], p[o + 6], p[o + 7]})
#define SC_PACK 0x7c7f
#define MFMA8QK(a, b) __builtin_amdgcn_mfma_scale_f32_32x32x64_f8f6f4(a, b, f32x16{}, 0, 0, 0, SC_PACK, 1, SC_PACK)
#define MFMA8PV(p, v, c) __builtin_amdgcn_mfma_scale_f32_32x32x64_f8f6f4(p, v, c, 1, 0, 0, SC_PACK, 0, SC_PACK)
template <bool NEAR>
__device__ __forceinline__ int ex4(const f32x16& P, int b, const LAS float* tb, int o) {
    float x0 = P[b], x1 = P[b + 1], x2 = P[b + 2], x3 = P[b + 3];
    if (NEAR) { x0 += tb[o]; x1 += tb[o + 1]; x2 += tb[o + 2]; x3 += tb[o + 3]; }
    x0 = EXP2F(x0); x1 = EXP2F(x1); x2 = EXP2F(x2); x3 = EXP2F(x3);
    int w; asm volatile("" : "=v"(w));
    w = __builtin_amdgcn_cvt_pk_bf8_f32(x0, x1, w, false);
    w = __builtin_amdgcn_cvt_pk_bf8_f32(x2, x3, w, true);
    return w;
}
#define MFMA8SUM(acc, p) asm volatile("v_mfma_scale_f32_16x16x128_f8f6f4 %0, %1, %2, %0, %3, %3 op_sel_hi:[0,0,0] blgp:1" : "+v"(acc) : "v"(aones), "v"(p), "v"(sc1))
template <bool NEAR>
__device__ __forceinline__ void tile_step(f32x16 (&o1)[4], f32x16 (&o2)[4], f32x4& s1, f32x4& s2, const LAS unsigned char* kslot, const LAS unsigned char* knext, const LAS unsigned char* vprev, const LAS unsigned char* qs,
                                          const LAS float* BT, int dist0, int lofsK, int lofsV, const i32x8 (&pp)[2], i32x8 (&pn)[2], i32x8& kf, i32x8& qf, const i32x8& aones, const int sc1, const i32x8& qg) {
    const LAS unsigned char* kb = K8ADDR(kslot); const LAS unsigned char* vp = V8ADDR(vprev); int dkn = (int)(knext - kslot); asm volatile("" : "+s"(dkn));
    const LAS float* tb = BT + (448 - dist0 + ((lofsK >> 9) & 4));
    i32x8 vf; f32x16 R0, R1;
    R0 = MFMA8QK(kf, qf);
    kf = LD8(kb, 512, 1536); vf = LD8(vp, 0, 2048);
    SB0();
    R1 = MFMA8QK(kf, qf);
    kf = LD8(kb, 4096, 5120);
    SB0();
    pn[0][0] = ex4<NEAR>(R0, 0, tb, 0);
    SB0();
    o1[0] = MFMA8PV(pp[0], vf, o1[0]);
    pn[0][1] = ex4<NEAR>(R0, 4, tb, 8);
    pn[0][2] = ex4<NEAR>(R0, 8, tb, 16);
    SB0();
    o2[0] = MFMA8PV(pp[1], vf, o2[0]);
    vf = LD8(vp, 512, 2560);
    pn[0][3] = ex4<NEAR>(R0, 12, tb, 24);
    SB0();
    R0 = MFMA8QK(kf, qg);
    kf = LD8(kb, 4608, 5632);
    pn[0][4] = ex4<NEAR>(R1, 0, tb, 32);
    SB0();
    o1[1] = MFMA8PV(pp[0], vf, o1[1]);
    MFMA8SUM(s1, pp[0]);
    pn[0][5] = ex4<NEAR>(R1, 4, tb, 40);
    pn[0][6] = ex4<NEAR>(R1, 8, tb, 48);
    SB0();
    o2[1] = MFMA8PV(pp[1], vf, o2[1]);
    vf = LD8(vp, 1024, 3072);
    pn[0][7] = ex4<NEAR>(R1, 12, tb, 56);
    SB0();
    R1 = MFMA8QK(kf, qg);
    { const LAS unsigned char* kn = kb + dkn; kf = LD8(kn, 0, 1024); }
    pn[1][0] = ex4<NEAR>(R0, 0, tb, 0);
    SB0();
    o1[2] = MFMA8PV(pp[0], vf, o1[2]);
    MFMA8SUM(s2, pp[1]);
    pn[1][1] = ex4<NEAR>(R0, 4, tb, 8);
    pn[1][2] = ex4<NEAR>(R0, 8, tb, 16);
    SB0();
    o2[2] = MFMA8PV(pp[1], vf, o2[2]);
    vf = LD8(vp, 1536, 3584);
    pn[1][3] = ex4<NEAR>(R0, 12, tb, 24);
    SB0();
    o1[3] = MFMA8PV(pp[0], vf, o1[3]);
    pn[1][4] = ex4<NEAR>(R1, 0, tb, 32);
    pn[1][5] = ex4<NEAR>(R1, 4, tb, 40);
    SB0();
    o2[3] = MFMA8PV(pp[1], vf, o2[3]);
    pn[1][6] = ex4<NEAR>(R1, 8, tb, 48);
    pn[1][7] = ex4<NEAR>(R1, 12, tb, 56);
    SB0();
}
__device__ __forceinline__ void pv_flush(f32x16 (&o1)[4], f32x16 (&o2)[4], const LAS unsigned char* vprev, int lofsK, int lofsV, const i32x8 (&pp)[2], f32x4& s1, f32x4& s2, const i32x8& aones, const int sc1) {
    const LAS unsigned char* vp = V8ADDR(vprev);
    i32x8 vf;
    vf = LD8(vp, 0, 2048);
    o1[0] = MFMA8PV(pp[0], vf, o1[0]);
    o2[0] = MFMA8PV(pp[1], vf, o2[0]);
    vf = LD8(vp, 512, 2560);
    o1[1] = MFMA8PV(pp[0], vf, o1[1]);
    o2[1] = MFMA8PV(pp[1], vf, o2[1]);
    vf = LD8(vp, 1024, 3072);
    o1[2] = MFMA8PV(pp[0], vf, o1[2]);
    o2[2] = MFMA8PV(pp[1], vf, o2[2]);
    vf = LD8(vp, 1536, 3584);
    o1[3] = MFMA8PV(pp[0], vf, o1[3]);
    o2[3] = MFMA8PV(pp[1], vf, o2[3]);
    MFMA8SUM(s1, pp[0]); MFMA8SUM(s2, pp[1]);
}
__device__ __forceinline__ void vtrans_phase(const Ctx& F, const bf16* Vb, unsigned char* V8T) {
    const int lane = F.lane; LAS unsigned char* blk = F.lds + F.wave * 8192;
    for (int it = F.vcu * 8 + F.wave; it < 8 * 256; it += F.G * 8) {
        const int h = it >> 8, T = it & 255;
#pragma unroll 4
        for (int i = 0; i < 16; ++i) { const int p = lane + 64 * i, key = p >> 4, ch = p & 15;
            const v4u w = *(const v4u*)(Vb + (size_t)(T * 64 + key) * 1024 + h * 128 + ch * 8);
            int lo = 0, hi4 = 0;
            lo = __builtin_amdgcn_cvt_pk_fp8_f32(pg8::bflo(w.x), pg8::bfhi(w.x), lo, false); lo = __builtin_amdgcn_cvt_pk_fp8_f32(pg8::bflo(w.y), pg8::bfhi(w.y), lo, true);
            hi4 = __builtin_amdgcn_cvt_pk_fp8_f32(pg8::bflo(w.z), pg8::bfhi(w.z), hi4, false); hi4 = __builtin_amdgcn_cvt_pk_fp8_f32(pg8::bflo(w.w), pg8::bfhi(w.w), hi4, true);
            const int pos = ((key >> 2) & 1) * 32 + ((key >> 5) & 1) * 16 + ((key >> 3) & 3) * 4 + (key & 3);
            LAS unsigned char* d = blk + (ch * 8) * 64 + pos;
            d[0 * 64] = (unsigned char)(lo); d[1 * 64] = (unsigned char)(lo >> 8); d[2 * 64] = (unsigned char)(lo >> 16); d[3 * 64] = (unsigned char)(lo >> 24);
            d[4 * 64] = (unsigned char)(hi4); d[5 * 64] = (unsigned char)(hi4 >> 8); d[6 * 64] = (unsigned char)(hi4 >> 16); d[7 * 64] = (unsigned char)(hi4 >> 24); }
        LDS_WAIT(); asm volatile("" ::: "memory");
        unsigned char* out = V8T + (size_t)it * 8192;
#pragma unroll
        for (int i = 0; i < 8; ++i) { const int p = lane + 64 * i; *(v4u*)(out + p * 16) = *(const LAS v4u*)(blk + p * 16); }
        LDS_WAIT(); asm volatile("" ::: "memory");
    }
}
__device__ __forceinline__ void epilogue(const Ctx& F, const f32x16 (&o1)[4], const f32x16 (&o2)[4], float l1, float l2, int h, int qw, bf16* Y, float lam, float oml, const float* subg) {
    const int lane = lane_id_opaque(), wid = F.wave, r32 = lane & 31, hi = lane >> 5;
    LAS float* wsf = (LAS float*)(F.lds + WS_OFF) + wid * 64;

    if (hi == 0) { wsf[r32] = 1.0f / l1; wsf[32 + r32] = lam / l2; }
    LDS_WAIT(); asm volatile("" ::: "memory");
    float gsub[4];
#pragma unroll
    for (int db = 0; db < 4; ++db) gsub[db] = subg[32 * db + r32] * oml;
#pragma unroll
    for (int r = 0; r < 16; ++r) {
        const int row = crow(r, hi); const float a = wsf[row], b = wsf[32 + row];
        float y[4]; float ss = 0.f;
#pragma unroll
        for (int db = 0; db < 4; ++db) { y[db] = o1[db][r] * a - o2[db][r] * b; ss += y[db] * y[db]; }
        ss = half_sum(ss);
        const float rs = __builtin_amdgcn_rsqf(ss * (1.0f / 128.0f) + EPS_);
        LAS unsigned char* sp = (r < 8 ? F.lds + wid * 4096 : F.lds + QS_OFF + wid * 4096) + (row & 15) * 256 + r32 * 2;
#pragma unroll
        for (int db = 0; db < 4; ++db) *(LAS bf16*)(sp + 64 * db) = f2bf(DBG_ATT_SCALE * y[db] * rs * gsub[db]);
    }
    LDS_WAIT(); asm volatile("" ::: "memory");
#pragma unroll
    for (int half = 0; half < 2; ++half) { const LAS unsigned char* stg = half ? F.lds + QS_OFF + wid * 4096 : F.lds + wid * 4096;
#pragma unroll
        for (int i = 0; i < 4; ++i) { const int p = lane + 64 * i, rowh = p >> 4, ch = p & 15;
            *(v4u*)(Y + (size_t)(qw + 16 * half + rowh) * 2048 + h * 128 + 8 * ch) = *(const LAS v4u*)(stg + rowh * 256 + ch * 16); } }
    asm volatile("s_waitcnt lgkmcnt(0)" ::: "memory"); __builtin_amdgcn_s_barrier(); asm volatile("" ::: "memory");
}
__device__ __forceinline__ void attn_unit(const Ctx& F, int h, int qb, const bf16* Qb, const unsigned char* K8, const unsigned char* V8T, bf16* Y, const float* bt2, float lam, float oml, const float* subg) {
    LAS unsigned char* lds = F.lds; const int lane = lane_id_opaque(), wid = F.wave, tid = wid * 64 + lane, r32 = lane & 31, hi = lane >> 5;
    const int q0 = qb * 256, NT = (q0 + 256) / 64, qw = q0 + 32 * wid;
    LAS float* BT = (LAS float*)(lds + BT_OFF);
    float btv = -INFINITY; { const int d = 448 - tid; if (d >= 0) btv = d < 128 ? bt2[d] : 0.f; }
    v4u qraw[2][4];
    { const bf16* Qrow = Qb + (size_t)(qw + r32) * 1024 + h * 128;
#pragma unroll
      for (int cp = 0; cp < 2; ++cp)
#pragma unroll
          for (int d0 = 0; d0 < 4; ++d0) qraw[cp][d0] = *(const v4u*)(Qrow + cp * 64 + d0 * 16 + hi * 8); }
    const unsigned klo = (unsigned)(lane * 1024 + h * 128 + wid * 16);
    const unsigned vlo = (unsigned)((64 * (wid >> 2) + lane) * 64 + (wid & 3) * 16);
    LAS unsigned char* kd = lds + wid * 1024; LAS unsigned char* vd = lds + VRING + (wid & 3) * 2048 + (wid >> 2) * 1024;
#define ATT_DMA(t, b_) do { const char* kp_ = (const char*)K8 + (size_t)(t) * (64 * 1024); const char* vp_ = (const char*)V8T + ((size_t)h * 256 + (t)) * 8192; asm volatile("" : "+s"(kp_), "+s"(vp_)); \
        glds(kp_ + klo, kd + (b_) * KSL8); glds(vp_ + vlo, vd + (b_) * VSL); } while (0)
#define ATT_SYNC(n_) do { asm volatile("s_waitcnt vmcnt(" #n_ ") lgkmcnt(0)" ::: "memory"); __builtin_amdgcn_s_barrier(); asm volatile("" ::: "memory"); } while (0)
    f32x16 o1[4], o2[4];
#pragma unroll
    for (int i = 0; i < 4; ++i) { o1[i] = f32x16{}; o2[i] = f32x16{}; }
    f32x4 s1 = {0.f, 0.f, 0.f, 0.f}, s2 = {0.f, 0.f, 0.f, 0.f};
    int one8 = (lane == 0 || lane == 32 || lane == 17 || lane == 49) ? 0x38383838 : 0; asm volatile("" : "+v"(one8));
    const i32x8 aones = {one8, one8, one8, one8, one8, one8, one8, one8};
    const int sc1 = SC_PACK;
    asm volatile("s_waitcnt lgkmcnt(0)" ::: "memory"); __builtin_amdgcn_s_barrier(); asm volatile("" ::: "memory");
    { unsigned z_ = 0u; asm volatile("" : "+v"(z_)); *(LAS v4u*)(lds + VRING + 3 * VSL + tid * 16) = v4u{z_, z_, z_, z_}; }
    ATT_DMA(0, 0); ATT_DMA(1, 1);
    BT[tid] = btv; if (tid < 32) BT[512 + tid] = -INFINITY;
    i32x8 q8[2];
    {
#pragma unroll
      for (int cp = 0; cp < 2; ++cp)
#pragma unroll
          for (int d0 = 0; d0 < 4; ++d0) { const v4u w = qraw[cp][d0];
              int lo = 0, hi4 = 0;
              lo = __builtin_amdgcn_cvt_pk_fp8_f32(8.0f * pg8::bflo(w.x), 8.0f * pg8::bfhi(w.x), lo, false); lo = __builtin_amdgcn_cvt_pk_fp8_f32(8.0f * pg8::bflo(w.y), 8.0f * pg8::bfhi(w.y), lo, true);
              hi4 = __builtin_amdgcn_cvt_pk_fp8_f32(8.0f * pg8::bflo(w.z), 8.0f * pg8::bfhi(w.z), hi4, false); hi4 = __builtin_amdgcn_cvt_pk_fp8_f32(8.0f * pg8::bflo(w.w), 8.0f * pg8::bfhi(w.w), hi4, true);
              q8[cp][2 * d0] = lo; q8[cp][2 * d0 + 1] = hi4; } }
    LAS unsigned char* qs = lds + QS_OFF + wid * 4096 + lane * 16;
#pragma unroll
    for (int cp = 0; cp < 2; ++cp) { *(LAS i32x4*)(qs + cp * 2048) = __builtin_shufflevector(q8[cp], q8[cp], 0, 1, 2, 3); *(LAS i32x4*)(qs + cp * 2048 + 1024) = __builtin_shufflevector(q8[cp], q8[cp], 4, 5, 6, 7); }
    ATT_SYNC(0);
    int lofsK = hi * 2048 + r32 * 16, lofsV = hi * 4096 + r32 * 16; asm volatile("" : "+v"(lofsK), "+v"(lofsV));
    i32x8 pA[2], pB[2]; i32x8 kf, qf = q8[0];
    pA[0] = i32x8{}; pA[1] = i32x8{};
    { const LAS unsigned char* kb0 = K8ADDR(lds); kf = LD8(kb0, 0, 1024); }
#define KS_(t_) (lds + ((t_) & 3) * KSL8)
#define VS_(t_) (lds + VRING + ((t_) & 3) * VSL)
    const int tA = q0 >= 191 ? (q0 - 191) / 64 + 1 : 0;
    for (int t = 0; t < tA; t += 2) {
        ATT_DMA(t + 2, (t + 2) & 3);
        tile_step<false>(o1, o2, s1, s2, KS_(t), KS_(t + 1), VS_(t + 3), qs, BT, 0, lofsK, lofsV, pA, pB, kf, qf, aones, sc1, q8[1]);
        ATT_SYNC(0);
        ATT_DMA(t + 3, (t + 3) & 3);
        tile_step<false>(o1, o2, s1, s2, KS_(t + 1), KS_(t + 2), VS_(t), qs, BT, 0, lofsK, lofsV, pB, pA, kf, qf, aones, sc1, q8[1]);
        ATT_SYNC(0);
    }
    int qwr = qw + (lane_id_opaque() & 31); asm volatile("" : "+v"(qwr));
    for (int t = tA; t < NT; ++t) {
        if (t + 2 < NT) ATT_DMA(t + 2, (t + 2) & 3);
        if (64 * t <= qw + 31) {
            tile_step<true>(o1, o2, s1, s2, KS_(t), KS_(t + 1), VS_(t + 3), qs, BT, qwr - 64 * t, lofsK, lofsV, pA, pB, kf, qf, aones, sc1, q8[1]);
            pA[0] = pB[0]; pA[1] = pB[1];
        }
        ATT_SYNC(0);
    }
    { const int tl = min(NT - 1, (qw + 31) >> 6); pv_flush(o1, o2, VS_(tl), lofsK, lofsV, pA, s1, s2, aones, sc1); }
#undef KS_
#undef VS_
#undef ATT_DMA
#undef ATT_SYNC
    asm volatile("s_nop 15\n\ts_nop 15\n\ts_nop 15\n\ts_nop 15\n\ts_nop 15\n\ts_nop 15" : "+v"(s1), "+v"(s2));
    const int r32e = lane_id_opaque() & 31;
    float l10 = bperm(s1[0], r32e & 15), l11 = bperm(s1[1], r32e & 15), l20 = bperm(s2[0], r32e & 15), l21 = bperm(s2[1], r32e & 15);
    asm volatile("" : "+v"(l10), "+v"(l11), "+v"(l20), "+v"(l21));
    const float l1s = (r32e & 16) ? l11 : l10, l2s = (r32e & 16) ? l21 : l20;
    epilogue(F, o1, o2, l1s, l2s, h, qw, Y, lam, oml, subg);
}
}

namespace mls {
constexpr int L = 128, NC = S_ / L;
constexpr int ST1 = 520;
constexpr int VT_OFF = 0, KT_OFF = 128 * ST1, TB_OFF = 2 * 128 * ST1;
__device__ __forceinline__ void step1_unit(const Ctx& F, int l, int h, int c, const float* LF, const float* IG, float* BC, float* AA, float* BL, float* ML,
                                           const bf16* MQKR, const bf16* MV, bf16* MQ, bf16* MK, const float* conv_w, const float* conv_b, bf16* UB, float* NU) {
    LAS unsigned char* lds = F.lds; const int lane = lane_id_opaque(), wid = F.wave, tid = wid * 64 + lane, hi = lane >> 5;
    const int t0 = c * L; LAS float* wkt = (LAS float*)(lds + TB_OFF);
    const size_t gi = (size_t)h * S_ + t0 + 2 * lane;
    float lf0 = 0.f, lf1 = 0.f, ig0 = 0.f, ig1 = 0.f;
    if (wid == 0) { lf0 = LF[gi]; lf1 = LF[gi + 1]; ig0 = IG[gi]; ig1 = IG[gi + 1]; }
    v4u vt[8];
#pragma unroll
    for (int i = 0; i < 8; ++i) { const int idx = tid + 512 * i, row = idx >> 5, pc = idx & 31; vt[i] = *(const v4u*)(MV + (size_t)(t0 + row) * 1024 + h * 256 + pc * 8); }
    v4u rawq[11], rawk[11];
    { const int dg = tid & 31, rg = tid >> 5;
#pragma unroll
      for (int rr = 0; rr < 11; ++rr) { const int t = t0 + 8 * rg + rr - 3; rawq[rr] = (v4u){0u, 0u, 0u, 0u}; rawk[rr] = (v4u){0u, 0u, 0u, 0u};
          if (t >= 0) { rawq[rr] = *(const v4u*)(MQKR + (size_t)t * 2048 + h * 256 + 8 * dg); rawk[rr] = *(const v4u*)(MQKR + (size_t)t * 2048 + 1024 + h * 256 + 8 * dg); } } }
    if (wid == 0) {
        float s = lf0 + lf1;
#pragma unroll
        for (int o = 1; o < 64; o <<= 1) { const float y = bperm(s, lane - o); if (lane >= o) s += y; }
        const float bc1 = s, bc0 = s - lf1, blast = bperm(s, 63);
        const float a0 = ig0 - bc0, a1 = ig1 - bc1, g0 = blast + a0, g1 = blast + a1;
        const float mloc = wave_max(fmaxf(g0, g1));
        wkt[2 * lane] = __expf(g0 - mloc); wkt[2 * lane + 1] = __expf(g1 - mloc);
        BC[gi] = bc0; BC[gi + 1] = bc1; AA[gi] = a0; AA[gi + 1] = a1;
        if (lane == 0) { BL[h * NC + c] = blast; ML[h * NC + c] = mloc; }
    }
    f32x4 cwa[2][4][2], cba[2][2];
#define CONV_LD(W_) do { const int cb_ = (W_) * 1024 + h * 256 + 8 * (tid & 31); _Pragma("unroll") for (int j = 0; j < 4; ++j) { cwa[W_][j][0] = *(const f32x4*)(conv_w + (size_t)j * 2048 + cb_); cwa[W_][j][1] = *(const f32x4*)(conv_w + (size_t)j * 2048 + cb_ + 4); } \
        cba[W_][0] = *(const f32x4*)(conv_b + cb_); cba[W_][1] = *(const f32x4*)(conv_b + cb_ + 4); } while (0)
    CONV_LD(0);
#pragma unroll
    for (int i = 0; i < 8; ++i) { const int idx = tid + 512 * i, row = idx >> 5, pc = idx & 31;
        LAS v2u* d = (LAS v2u*)(lds + VT_OFF + row * ST1 + pc * 16); d[0] = (v2u){vt[i].x, vt[i].y}; d[1] = (v2u){vt[i].z, vt[i].w}; }
    CONV_LD(1);
#undef CONV_LD
    __syncthreads();
    { const int dg = tid & 31, rg = tid >> 5;
#pragma unroll
      for (int which = 0; which < 2; ++which) {
        float cw[4][8], cbias[8];
#pragma unroll
        for (int j = 0; j < 4; ++j) { const f32x4 w0 = cwa[which][j][0], w1 = cwa[which][j][1];
#pragma unroll
            for (int e = 0; e < 4; ++e) { cw[j][e] = w0[e]; cw[j][4 + e] = w1[e]; } }
        { const f32x4 b0 = cba[which][0], b1 = cba[which][1];
#pragma unroll
          for (int e = 0; e < 4; ++e) { cbias[e] = b0[e]; cbias[4 + e] = b1[e]; } }
        v4u raw[11];
#pragma unroll
        for (int rr = 0; rr < 11; ++rr) raw[rr] = which ? rawk[rr] : rawq[rr];
#pragma unroll
        for (int r = 0; r < 8; ++r) {
            float y[8];
#pragma unroll
            for (int e = 0; e < 8; ++e) y[e] = cbias[e];
#pragma unroll
            for (int j = 0; j < 4; ++j) { const v4u w = raw[r + j];
                y[0] += cw[j][0] * pg8::bflo(w.x); y[1] += cw[j][1] * pg8::bfhi(w.x); y[2] += cw[j][2] * pg8::bflo(w.y); y[3] += cw[j][3] * pg8::bfhi(w.y);
                y[4] += cw[j][4] * pg8::bflo(w.z); y[5] += cw[j][5] * pg8::bfhi(w.z); y[6] += cw[j][6] * pg8::bflo(w.w); y[7] += cw[j][7] * pg8::bfhi(w.w); }
            const float scl = which ? 0.0625f : 1.0f;
#pragma unroll
            for (int e = 0; e < 8; ++e) y[e] = y[e] * pg8::sigm(y[e]) * scl;
            const int row = 8 * rg + r;
            const v4u o = (v4u){pk2(y[0], y[1]), pk2(y[2], y[3]), pk2(y[4], y[5]), pk2(y[6], y[7])};
            *(v4u*)((which ? MK : MQ) + (size_t)(t0 + row) * 1024 + h * 256 + 8 * dg) = o;
            if (which) { const float wk = wkt[row];
                LAS v2u* d = (LAS v2u*)(lds + KT_OFF + row * ST1 + dg * 16);
                d[0] = (v2u){pk2(y[0] * wk, y[1] * wk), pk2(y[2] * wk, y[3] * wk)}; d[1] = (v2u){pk2(y[4] * wk, y[5] * wk), pk2(y[6] * wk, y[7] * wk)}; }
        }
      }
    }
    __syncthreads();
    if (tid < 256) { float s = 0.f; const LAS bf16* kp = (const LAS bf16*)(lds + KT_OFF) + tid;
#pragma unroll 8
        for (int r = 0; r < L; ++r) s += bf2f(kp[r * (ST1 / 2)]);
        NU[((size_t)h * NC + c) * 256 + tid] = s; }
    { const int eb = wid >> 1, dh = wid & 1;
      f32x16 acc[2][4];
#pragma unroll
      for (int mi = 0; mi < 2; ++mi)
#pragma unroll
          for (int ni = 0; ni < 4; ++ni) acc[mi][ni] = f32x16{};
      const int trow = 8 * hi + ((lane & 15) >> 2), tcol = 16 * ((lane >> 4) & 1) + 4 * (lane & 3);
      const LAS unsigned char* va = lds + VT_OFF + trow * ST1 + (64 * eb + tcol) * 2;
      const LAS unsigned char* ka = lds + KT_OFF + trow * ST1 + (128 * dh + tcol) * 2;
#pragma unroll 1
      for (int ks = 0; ks < 8; ++ks) {
          bf16x8 a[2], b[4];
#pragma unroll
          for (int mi = 0; mi < 2; ++mi) a[mi] = tr8(va + ks * 16 * ST1 + mi * 64, 4 * ST1);
#pragma unroll
          for (int ni = 0; ni < 4; ++ni) b[ni] = tr8(ka + ks * 16 * ST1 + ni * 64, 4 * ST1);
#pragma unroll
          for (int mi = 0; mi < 2; ++mi)
#pragma unroll
              for (int ni = 0; ni < 4; ++ni) acc[mi][ni] = MFMA32(a[mi], b[ni], acc[mi][ni]);
      }
      __syncthreads();
      LAS unsigned char* stg = lds + wid * 17408;
#pragma unroll
      for (int mi = 0; mi < 2; ++mi)
#pragma unroll
          for (int ni = 0; ni < 4; ++ni)
#pragma unroll
              for (int r = 0; r < 16; ++r) *(LAS bf16*)(stg + (32 * mi + crow(r, hi)) * 272 + (32 * ni + (lane & 31)) * 2) = f2bf(acc[mi][ni][r]);
      LDS_WAIT(); asm volatile("" ::: "memory");
      bf16* up = UB + ((size_t)h * NC + c) * 65536 + (size_t)(64 * eb) * 256 + 128 * dh;
#pragma unroll
      for (int i = 0; i < 16; ++i) { const int p = lane + 64 * i, row = p >> 4, ch = p & 15; *(v4u*)(up + (size_t)row * 256 + 8 * ch) = *(const LAS v4u*)(stg + row * 272 + ch * 16); }
    }
    __syncthreads();
}
__device__ __forceinline__ double bperm64(double v, int src_lane) { const unsigned long long b = __builtin_bit_cast(unsigned long long, v);
    const unsigned lo = (unsigned)__builtin_amdgcn_ds_bpermute(src_lane << 2, (int)(unsigned)b), hi = (unsigned)__builtin_amdgcn_ds_bpermute(src_lane << 2, (int)(unsigned)(b >> 32));
    return __builtin_bit_cast(double, ((unsigned long long)hi << 32) | lo); }
struct GateTab { float fa0, fb0, mp0, fa1, fb1, mp1; };
__device__ __forceinline__ GateTab gate_tables(const float* BL, const float* ML, int h, int lane) {
    const float blf0 = BL[h * NC + 2 * lane], blf1 = BL[h * NC + 2 * lane + 1], mlf0 = ML[h * NC + 2 * lane], mlf1 = ML[h * NC + 2 * lane + 1];
    const double bl0 = blf0, bl1 = blf1, ml0 = mlf0, ml1 = mlf1;
    double ps = bl0 + bl1;
#pragma unroll
    for (int o = 1; o < 64; o <<= 1) { const double y = bperm64(ps, lane - o); if (lane >= o) ps += y; }
    const double S1 = ps, S0 = ps - bl1, t0 = ml0 - S0, t1 = ml1 - S1;
    double pmx = fmax(t0, t1);
#pragma unroll
    for (int o = 1; o < 64; o <<= 1) { const double y = bperm64(pmx, lane - o); if (lane >= o) pmx = fmax(pmx, y); }
    double prev = bperm64(pmx, lane - 1); if (lane == 0) prev = -1.0e300;
    const double PM0 = fmax(prev, t0), m0 = S0 + fmax(0.0, PM0), m1 = S1 + fmax(0.0, pmx);
    double mprev0 = bperm64(m1, lane - 1); if (lane == 0) mprev0 = 0.0;
    GateTab g; g.fa0 = __expf((float)(bl0 + mprev0 - m0)); g.fb0 = __expf((float)(ml0 - m0)); g.mp0 = (float)mprev0;
    g.fa1 = __expf((float)(bl1 + m0 - m1)); g.fb1 = __expf((float)(ml1 - m1)); g.mp1 = (float)m0;
    return g;
}
__device__ __forceinline__ float rdl(float v, int l) { return __uint_as_float((unsigned)__builtin_amdgcn_readlane((int)__float_as_uint(v), l)); }
__device__ __forceinline__ void scan_phase(const Ctx& F, const bf16* UB, bf16* CST, const float* BL, const float* ML, float* MP, const float* NU, float* NST) {
    const int gt = F.vcu * 512 + F.tid, lane = F.tid & 63;
    if (gt < 65536) {
        const int h = gt >> 14, e = (gt >> 6) & 255, d0 = 4 * (gt & 63);
        const size_t base = (size_t)h * NC * 65536 + (size_t)e * 256 + d0;
        v2u ua[16], ub[16];
#pragma unroll
        for (int i = 0; i < 16; ++i) ua[i] = *(const v2u*)(UB + base + (size_t)i * 65536);
        const GateTab g = gate_tables(BL, ML, h, lane);
        if ((gt & 16383) < 64) { MP[h * NC + 2 * lane] = g.mp0; MP[h * NC + 2 * lane + 1] = g.mp1; }
        float C0 = 0.f, C1 = 0.f, C2 = 0.f, C3 = 0.f;
#define SCAN_STEPS(U, CB) _Pragma("unroll") for (int i = 0; i < 16; ++i) { \
                *(v2u*)(CST + base + (size_t)((CB) + i) * 65536) = (v2u){pk2(C0, C1), pk2(C2, C3)}; \
                const float fa = rdl((i & 1) ? g.fa1 : g.fa0, ((CB) >> 1) + (i >> 1)), fb = rdl((i & 1) ? g.fb1 : g.fb0, ((CB) >> 1) + (i >> 1)); \
                C0 = fa * C0 + fb * pg8::bflo(U[i].x); C1 = fa * C1 + fb * pg8::bfhi(U[i].x); C2 = fa * C2 + fb * pg8::bflo(U[i].y); C3 = fa * C3 + fb * pg8::bfhi(U[i].y); }
#pragma unroll 1
        for (int c8 = 0; c8 < NC; c8 += 32) {
#pragma unroll
            for (int i = 0; i < 16; ++i) ub[i] = *(const v2u*)(UB + base + (size_t)(c8 + 16 + i) * 65536);
            SCAN_STEPS(ua, c8)
            if (c8 + 32 < NC) {
#pragma unroll
                for (int i = 0; i < 16; ++i) ua[i] = *(const v2u*)(UB + base + (size_t)(c8 + 32 + i) * 65536); }
            SCAN_STEPS(ub, c8 + 16)
        }
#undef SCAN_STEPS
    } else if (gt < 65536 + 256) {
        const int idx = gt - 65536, h = idx >> 6, d0 = 4 * (idx & 63);
        f32x4 ua[16], ub[16];
#pragma unroll
        for (int i = 0; i < 16; ++i) ua[i] = *(const f32x4*)(NU + ((size_t)h * NC + i) * 256 + d0);
        const GateTab g = gate_tables(BL, ML, h, lane);
        f32x4 n = {0.f, 0.f, 0.f, 0.f};
#define NSCAN_STEPS(U, CB) _Pragma("unroll") for (int i = 0; i < 16; ++i) { \
                *(f32x4*)(NST + ((size_t)h * NC + (CB) + i) * 256 + d0) = n; \
                const float fa = rdl((i & 1) ? g.fa1 : g.fa0, ((CB) >> 1) + (i >> 1)), fb = rdl((i & 1) ? g.fb1 : g.fb0, ((CB) >> 1) + (i >> 1)); \
                n = fa * n + fb * U[i]; }
#pragma unroll 1
        for (int c8 = 0; c8 < NC; c8 += 32) {
#pragma unroll
            for (int i = 0; i < 16; ++i) ub[i] = *(const f32x4*)(NU + ((size_t)h * NC + c8 + 16 + i) * 256 + d0);
            NSCAN_STEPS(ua, c8)
            if (c8 + 32 < NC) {
#pragma unroll
                for (int i = 0; i < 16; ++i) ua[i] = *(const f32x4*)(NU + ((size_t)h * NC + c8 + 32 + i) * 256 + d0); }
            NSCAN_STEPS(ub, c8 + 16)
        }
#undef NSCAN_STEPS
    }
}
constexpr int ST3 = 528;
constexpr int K3_OFF = 0, V3_OFF = 128 * ST3, T3_OFF = 2 * 128 * ST3;
__device__ __forceinline__ void step3_unit(const Ctx& F, int h, int c, const bf16* MQ, const bf16* MK, const bf16* MV, const bf16* CST, const float* NST, const float* MP, const float* AA, const float* BC,
                                           const bf16* MO, const float* mhg, bf16* Y) {
    LAS unsigned char* lds = F.lds; const int lane = lane_id_opaque(), wid = F.wave, tid = wid * 64 + lane, r32 = lane & 31, hi = lane >> 5;
    const int t0 = c * L;
    LAS float* aat = (LAS float*)(lds + T3_OFF); LAS float* att_ = aat + 128; LAS float* ait = aat + 256; LAS float* nvt = aat + 384; LAS float* pst = aat + 640; LAS float* rvt = aat + 896;
    const size_t gi = (size_t)h * S_ + t0 + 2 * lane; float a0 = 0.f, a1 = 0.f, mp = 0.f; f32x4 nv4 = {0.f, 0.f, 0.f, 0.f};
    if (wid == 0) { a0 = AA[gi]; a1 = AA[gi + 1]; mp = MP[h * NC + c]; }
    if (wid == 1) nv4 = *(const f32x4*)(NST + ((size_t)h * NC + c) * 256 + 4 * lane);
    const int rg = wid >> 1, eh = wid & 1; const int tr = 32 * rg + r32;
    const float bcv = BC[(size_t)h * S_ + t0 + tr];
    float gm[4];
#pragma unroll
    for (int db = 0; db < 4; ++db) gm[db] = mhg[128 * eh + 32 * db + r32];
    bf16x8 qf[16];
    { const bf16* qp = MQ + (size_t)(t0 + tr) * 1024 + h * 256 + 8 * hi;
#pragma unroll
      for (int k0 = 0; k0 < 16; ++k0) qf[k0] = *(const bf16x8*)(qp + 16 * k0); }
    { const bf16* cbase = CST + ((size_t)h * NC + c) * 65536;
#pragma unroll
      for (int i = 0; i < 16; ++i) { const int idx = tid + 512 * i, row = idx >> 5, pc = idx & 31;
          *(LAS v4u*)(lds + row * ST3 + pc * 16) = *(const v4u*)(cbase + (size_t)row * 256 + pc * 8); } }
    if (wid == 0) {
        float s = fmaxf(a0, a1);
#pragma unroll
        for (int o = 1; o < 64; o <<= 1) { const float y = bperm(s, lane - o); if (lane >= o) s = fmaxf(s, y); }
        float prev = bperm(s, lane - 1); if (lane == 0) prev = -INFINITY;
        const float A0 = fmaxf(mp, fmaxf(prev, a0)), A1 = fmaxf(mp, s);
        aat[2 * lane] = a0; aat[2 * lane + 1] = a1; att_[2 * lane] = A0; att_[2 * lane + 1] = A1; ait[2 * lane] = __expf(mp - A0); ait[2 * lane + 1] = __expf(mp - A1);
    }
    if (wid == 1) *(LAS f32x4*)(nvt + 4 * lane) = nv4;
    __syncthreads();
    v4u kreg[8], vreg[8];
#pragma unroll
    for (int i = 0; i < 8; ++i) { const int idx = tid + 512 * i, row = idx >> 5, pc = idx & 31;
        kreg[i] = *(const v4u*)(MK + (size_t)(t0 + row) * 1024 + h * 256 + pc * 8); vreg[i] = *(const v4u*)(MV + (size_t)(t0 + row) * 1024 + h * 256 + pc * 8); }
    f32x16 acc[4];
#pragma unroll
    for (int db = 0; db < 4; ++db) acc[db] = f32x16{};
    { const LAS unsigned char* cb = lds + (128 * eh + r32) * ST3 + 16 * hi;
#pragma unroll
      for (int k0 = 0; k0 < 16; ++k0) {
          bf16x8 cf[4];
#pragma unroll
          for (int db = 0; db < 4; ++db) cf[db] = *(const LAS bf16x8*)(cb + (32 * db) * ST3 + 32 * k0);
#pragma unroll
          for (int db = 0; db < 4; ++db) acc[db] = MFMA32(qf[k0], cf[db], acc[db]);
      }
    }
#pragma unroll
    for (int r = 0; r < 16; ++r) { const float a = ait[32 * rg + crow(r, hi)];
#pragma unroll
        for (int db = 0; db < 4; ++db) acc[db][r] *= a; }
    __syncthreads();
#pragma unroll
    for (int i = 0; i < 8; ++i) { const int idx = tid + 512 * i, row = idx >> 5, pc = idx & 31;
        *(LAS v4u*)(lds + K3_OFF + row * ST3 + pc * 16) = kreg[i]; *(LAS v4u*)(lds + V3_OFF + row * ST3 + pc * 16) = vreg[i]; }
    __syncthreads();
    float nq = 0.f;
#pragma unroll
    for (int k0 = 0; k0 < 16; ++k0) { const v4u w = __builtin_bit_cast(v4u, qf[k0]); const LAS float* np = nvt + 16 * k0 + 8 * hi;
        nq += pg8::bflo(w.x) * np[0] + pg8::bfhi(w.x) * np[1] + pg8::bflo(w.y) * np[2] + pg8::bfhi(w.y) * np[3] + pg8::bflo(w.z) * np[4] + pg8::bfhi(w.z) * np[5] + pg8::bflo(w.w) * np[6] + pg8::bfhi(w.w) * np[7]; }
    nq = swap_add(nq);
    const float At = att_[tr];
    float dsum = 0.f;
    const LAS unsigned char* vb = lds + V3_OFF + (4 * hi + ((lane & 15) >> 2)) * ST3 + (128 * eh + 16 * ((lane >> 4) & 1) + 4 * (lane & 3)) * 2;
    for (int kt = 0; kt <= (rg >> 1); ++kt) {
        f32x16 p0 = f32x16{}, p1 = f32x16{};
        const LAS unsigned char* kb = lds + K3_OFF + (64 * kt + r32) * ST3 + 16 * hi;
#pragma unroll
        for (int k0 = 0; k0 < 16; ++k0) { const bf16x8 ka = *(const LAS bf16x8*)(kb + 32 * k0), kc = *(const LAS bf16x8*)(kb + 32 * ST3 + 32 * k0);
            p0 = MFMA32(ka, qf[k0], p0); p1 = MFMA32(kc, qf[k0], p1); }
#pragma unroll
        for (int r = 0; r < 16; ++r) { const int s0 = 64 * kt + crow(r, hi), s1 = s0 + 32;
            const float w0 = s0 <= tr ? __builtin_amdgcn_exp2f((aat[s0] - At) * LOG2E_) : 0.f, w1 = s1 <= tr ? __builtin_amdgcn_exp2f((aat[s1] - At) * LOG2E_) : 0.f;
            p0[r] *= w0; p1[r] *= w1; dsum += p0[r] + p1[r]; }
        v4u pw[4];
        pw[0] = (v4u){pk2(p0[0], p0[1]), pk2(p0[2], p0[3]), pk2(p0[4], p0[5]), pk2(p0[6], p0[7])};
        pw[1] = (v4u){pk2(p0[8], p0[9]), pk2(p0[10], p0[11]), pk2(p0[12], p0[13]), pk2(p0[14], p0[15])};
        pw[2] = (v4u){pk2(p1[0], p1[1]), pk2(p1[2], p1[3]), pk2(p1[4], p1[5]), pk2(p1[6], p1[7])};
        pw[3] = (v4u){pk2(p1[8], p1[9]), pk2(p1[10], p1[11]), pk2(p1[12], p1[13]), pk2(p1[14], p1[15])};
#pragma unroll
        for (int ks = 0; ks < 4; ++ks)
#pragma unroll
            for (int db = 0; db < 4; ++db) { const bf16x8 vf = tr8(vb + (64 * kt + 16 * ks) * ST3 + db * 64, 8 * ST3); acc[db] = MFMA32(__builtin_bit_cast(bf16x8, pw[ks]), vf, acc[db]); }
    }
    v4u mo[8];
#pragma unroll
    for (int i = 0; i < 8; ++i) { const int p = lane + 64 * i; mo[i] = *(const v4u*)(MO + (size_t)(t0 + 32 * rg + (p >> 4)) * 1024 + h * 256 + 128 * eh + 8 * (p & 15)); }
    dsum = swap_add(dsum);
    { const float den = dsum + ait[tr] * nq; const float mt = bcv + At;
      if (hi == 0) rvt[wid * 32 + r32] = 1.0f / fmaxf(fabsf(den), __expf(-mt)); }
    LDS_WAIT(); asm volatile("" ::: "memory");
    float rv[16];
#pragma unroll
    for (int r = 0; r < 16; ++r) { rv[r] = rvt[wid * 32 + crow(r, hi)]; float ss = 0.f;
#pragma unroll
        for (int db = 0; db < 4; ++db) { acc[db][r] *= rv[r]; ss += acc[db][r] * acc[db][r]; }
        ss = half_sum(ss); if (r32 == 0) pst[wid * 32 + crow(r, hi)] = ss; }
    __syncthreads();
    LAS unsigned char* stg = lds + K3_OFF + wid * 8704;
#pragma unroll
    for (int r = 0; r < 16; ++r) { const int row = crow(r, hi); const float tot = pst[wid * 32 + row] + pst[(wid ^ 1) * 32 + row];
        const float rs = __builtin_amdgcn_rsqf(tot * (1.0f / 256.0f) + EPS_);
#pragma unroll
        for (int db = 0; db < 4; ++db) *(LAS bf16*)(stg + row * 272 + (32 * db + r32) * 2) = f2bf(acc[db][r] * rs * gm[db]); }
    LDS_WAIT(); asm volatile("" ::: "memory");
#pragma unroll
    for (int i = 0; i < 8; ++i) { const int p = lane + 64 * i, row = p >> 4, ch = p & 15;
        const v4u hv = *(const LAS v4u*)(stg + row * 272 + ch * 16); const v4u mv = mo[i]; v4u o;
        o.x = pk2(DBG_MLS_SCALE * pg8::bflo(hv.x) * pg8::bflo(mv.x), DBG_MLS_SCALE * pg8::bfhi(hv.x) * pg8::bfhi(mv.x)); o.y = pk2(DBG_MLS_SCALE * pg8::bflo(hv.y) * pg8::bflo(mv.y), DBG_MLS_SCALE * pg8::bfhi(hv.y) * pg8::bfhi(mv.y));
        o.z = pk2(DBG_MLS_SCALE * pg8::bflo(hv.z) * pg8::bflo(mv.z), DBG_MLS_SCALE * pg8::bfhi(hv.z) * pg8::bfhi(mv.z)); o.w = pk2(DBG_MLS_SCALE * pg8::bflo(hv.w) * pg8::bflo(mv.w), DBG_MLS_SCALE * pg8::bfhi(hv.w) * pg8::bfhi(mv.w));
        *(v4u*)(Y + (size_t)(t0 + 32 * rg + row) * 2048 + 1024 + h * 256 + 128 * eh + 8 * ch) = o; }
    __syncthreads();
}
}

#ifndef REPMASK
#define REPMASK 0
#endif
#ifndef PHMASK
#define PHMASK 0x3fff
#endif
constexpr int NPH_LAYER = 12, NPHASES = 2 + DEPTH_ * NPH_LAYER;
struct Args { const float* in[22]; float* out; unsigned char* ws; int ph_lo, ph_hi; };
__global__ void __launch_bounds__(512, 2) fwd(Args args) {
    extern __shared__ __attribute__((aligned(16))) unsigned char lds_raw[];
    Ctx F;
    F.lds = (LAS unsigned char*)lds_raw;
    F.tid = threadIdx.x; F.lane = F.tid & 63; F.wave = __builtin_amdgcn_readfirstlane(F.tid >> 6);
    F.G = gridDim.x; { const int bx = blockIdx.x; F.vcu = (F.G % 8 == 0) ? (bx % 8) * (F.G / 8) + bx / 8 : bx; }
    volatile LAS unsigned* MISC = (volatile LAS unsigned*)(F.lds + MISC_OFF);
    if (F.tid < 64) MISC[F.tid] = 0u;
    __syncthreads();
    unsigned char* ws = args.ws;
    const int lo = args.ph_lo, hi = args.ph_hi;
    const bool use_bar = (hi - lo) > 1;
    XcdBarrier bar; bar.bar = (unsigned*)(ws + WS_CTL) + 1024; bar.x = 0; bar.st = nullptr;
    if (use_bar) bar = xcd_barrier_post((unsigned*)(ws + WS_CTL) + 1024, MISC + 8);
#define IN(k) (lo <= (k) && (k) < hi)
#define FRESH(Fx) Ctx Fx = F; Fx.lane = lane_id_opaque(); Fx.tid = Fx.wave * 64 + Fx.lane; asm volatile("" : "+s"(Fx.vcu), "+s"(Fx.G)); unsigned char* wsl = ws; asm volatile("" : "+s"(wsl)); int lq = l; asm volatile("" : "+s"(lq))
#define SEAM_(k, X) do { if (IN((k) + 1)) { XcdBarrier b_ = bar; asm volatile("" : "+s"(b_.bar)); xcd_barrier<X>(b_, F.wave == 0 && lane_id_opaque() == 0); } } while (0)
#define SEAM(k) SEAM_(k, false)
    const float* const* in = args.in;
    float* xout = args.out;
#define P_BF(off) ((bf16*)(wsl + (off)))
#define P_F32(off) ((float*)(wsl + (off)))
#define L_MOD ((const float*)(wsl + WS_MOD) + lq * 6144)
#define L_PAR ((const float*)(wsl + WS_PAR) + (size_t)lq * PAR_L)
#define L_WL (wsl + ((lq & 1) ? WS_W2 : WS_W))
#define L_XSRC ((lq == 0) ? in[0] : xout)
#define L_B1(ll) ((u64*)(wsl + WS_B1) + ((ll) & 1) * 4096)
    if (IN(0) && (PHMASK >> 12 & 1)) { prologue_a(F, in[1], in[2], (float*)(ws + WS_MODP)); wconv_layer(F, in, ws + WS_W, 0, 0, nullptr, nullptr, nullptr, 1);     SEAM(0); }
    if (IN(1) && (PHMASK >> 13 & 1)) { prologue_b(F, in, ws); __syncthreads(); SEAM(1); }

    for (int l = 0; l < DEPTH_; ++l) {
        const int pb = 2 + NPH_LAYER * l;
        if (IN(pb + 0) && (PHMASK >> 0 & 1)) { FRESH(Fp);
          _Pragma("unroll 1") for (int rep_ = 0; rep_ < 1 + ((REPMASK >> 0) & 1); ++rep_) {
            if (lq == 0) wconv_layer(Fp, in, L_WL, 0, 0, L_PAR, L_MOD, L_B1(0), 2);
            norm_phase<true>(Fp, L_XSRC, P_BF(WS_XN), L_PAR + PR_NMG, L_MOD + 0, L_MOD + 1024, L_PAR + PR_GW, L_PAR + PR_BIG, L_PAR + PR_BFG, P_F32(WS_IG), P_F32(WS_LF), (u64*)(wsl + WS_SS), L_B1(lq + 1), wsl + WS_YAM);
            SEAM(pb + 0);
          }
        }
        if (IN(pb + 1) && (PHMASK >> 1 & 1)) { FRESH(Fp);
          _Pragma("unroll 1") for (int rep_ = 0; rep_ < 1 + ((REPMASK >> 1) & 1); ++rep_) {
            pg8::EpiProj E{wsl, L_PAR + PR_QNG, L_PAR + PR_KNG};
#if PROJ8
            {
                constexpr int NT8 = 36 - (P8_HI - P8_LO); pg8::Gemm g{P_BF(WS_YAM), (const bf16*)(L_WL + W_IN), S_, NT8 * 256, 512, 1024, 1024}; pg8::SubsetOrder<P8_LO, P8_HI - P8_LO> So; So.init(S_, NT8 * 256, Fp.G, (int)blockIdx.x);
                pg8::gemm_phase<pg8::EpiProj, pg8::SubsetOrder<P8_LO, P8_HI - P8_LO>, true, true, true>(Fp.lds, g, So, E, Fp.wave); }
#if P8_HI > P8_LO
            {
                constexpr int NTB = P8_HI - P8_LO; pg8::Gemm g{P_BF(WS_XN), (const bf16*)(L_WL + W_IN), S_, NTB * 256, 1024, 1024, 1024}; pg8::SubsetOrder<0, P8_LO> So; So.init(S_, NTB * 256, Fp.G, (int)blockIdx.x);
                pg8::gemm_phase<pg8::EpiProj, pg8::SubsetOrder<0, P8_LO>, true, true>(Fp.lds, g, So, E, Fp.wave); }
#endif
#else
            { pg8::Gemm g{P_BF(WS_XN), (const bf16*)(L_WL + W_IN), S_, NIN_, 1024, 1024, 1024}; pg8::StaticOrder So; So.init(S_, NIN_, Fp.G, (int)blockIdx.x);
              pg8::gemm_phase<pg8::EpiProj, pg8::StaticOrder, true, true>(Fp.lds, g, So, E, Fp.wave); }
#endif
            SEAM(pb + 1);
          }
        }
        if (IN(pb + 2) && (PHMASK >> 2 & 1)) { FRESH(Fp);
          _Pragma("unroll 1") for (int rep_ = 0; rep_ < 1 + ((REPMASK >> 2) & 1); ++rep_) {
            const float* lt = (const float*)(wsl + WS_TAB + 4096) + lq * 4; const float lam = __uint_as_float(__builtin_amdgcn_readfirstlane(__float_as_uint(lt[0]))), oml = __uint_as_float(__builtin_amdgcn_readfirstlane(__float_as_uint(lt[1])));
            if (Fp.wave >= 4) __builtin_amdgcn_s_setprio(1);
            for (int p = Fp.vcu; p < 256; p += Fp.G) {
                const int h = p >> 5, s = p & 31;
#pragma unroll 1
                for (int i = 0; i < 2; ++i)
                    att::attn_unit(Fp, h, i ? s : 63 - s, P_BF(WS_Q), (const unsigned char*)(wsl + WS_K), (const unsigned char*)(wsl + WS_V8T), P_BF(WS_YAM), (const float*)(wsl + WS_TAB) + h * 128, lam, oml, L_PAR + PR_SUBG);
            }
            __builtin_amdgcn_s_setprio(0);
            SEAM_(pb + 2, true);
          }
        }
        if (IN(pb + 3) && (PHMASK >> 3 & 1)) { FRESH(Fp);
          _Pragma("unroll 1") for (int rep_ = 0; rep_ < 1 + ((REPMASK >> 3) & 1); ++rep_) {
            for (int u = Fp.vcu; u < 4 * mls::NC; u += Fp.G)
                mls::step1_unit(Fp, lq, u >> 7, u & 127, P_F32(WS_LF), P_F32(WS_IG), P_F32(WS_BC), P_F32(WS_AA), P_F32(WS_BL), P_F32(WS_ML), P_BF(WS_MQKR), P_BF(WS_MV), P_BF(WS_MQ), P_BF(WS_MK), L_PAR + PR_CONVW, L_PAR + PR_CONVB, P_BF(WS_UB), P_F32(WS_NU));
            SEAM(pb + 3);
          }
        }
        if (IN(pb + 4) && (PHMASK >> 4 & 1)) { FRESH(Fp);
            _Pragma("unroll 1") for (int rep_ = 0; rep_ < 1 + ((REPMASK >> 4) & 1); ++rep_) { if (Fp.vcu < 129 || lq + 1 >= DEPTH_) mls::scan_phase(Fp, P_BF(WS_UB), P_BF(WS_CST), P_F32(WS_BL), P_F32(WS_ML), P_F32(WS_MP), P_F32(WS_NU), P_F32(WS_NST));
                else wconv_layer(Fp, in, wsl + (((lq + 1) & 1) ? WS_W2 : WS_W), lq + 1, 129, (const float*)(wsl + WS_PAR) + (size_t)(lq + 1) * PAR_L, (const float*)(wsl + WS_MOD) + (lq + 1) * 6144, L_B1(lq + 1));
                SEAM(pb + 4);  }
        }
        if (IN(pb + 5) && (PHMASK >> 5 & 1)) { FRESH(Fp);
          _Pragma("unroll 1") for (int rep_ = 0; rep_ < 1 + ((REPMASK >> 5) & 1); ++rep_) {
            for (int u = Fp.vcu; u < 4 * mls::NC; u += Fp.G)
                mls::step3_unit(Fp, u >> 7, u & 127, P_BF(WS_MQ), P_BF(WS_MK), P_BF(WS_MV), P_BF(WS_CST), P_F32(WS_NST), P_F32(WS_MP), P_F32(WS_AA), P_F32(WS_BC), P_BF(WS_MO), L_PAR + PR_MHG, P_BF(WS_YAM));
            SEAM(pb + 5);
          }
        }
        if (IN(pb + 6) && (PHMASK >> 6 & 1)) { FRESH(Fp);
          _Pragma("unroll 1") for (int rep_ = 0; rep_ < 1 + ((REPMASK >> 6) & 1); ++rep_) {
            pg8::Gemm g{P_BF(WS_YAM), (const bf16*)(L_WL + W_A), S_, 1024, 2048, 2048, 2048}; pg8::StaticOrder So; So.init(S_, 1024, Fp.G, (int)blockIdx.x);
            pg8::EpiMerge E{P_BF(WS_XN), 1024, P_BF(WS_GAM), 2048};
            pg8::gemm_phase<pg8::EpiMerge, pg8::StaticOrder, true, true>(Fp.lds, g, So, E, Fp.wave);
            SEAM(pb + 7);
          }
        }
        if (IN(pb + 8) && (PHMASK >> 8 & 1)) { FRESH(Fp);
          _Pragma("unroll 1") for (int rep_ = 0; rep_ < 1 + ((REPMASK >> 8) & 1); ++rep_) {
            { const int gt = Fp.vcu * 512 + Fp.tid; if (gt < 4096) P_F32(WS_B1F)[gt] = fx_dec(L_B1(lq)[gt], 1.0f / B1Q_); }
            pg8::Gemm g{P_BF(WS_XN), (const bf16*)(L_WL + W_OUT), S_, 1024, 1024, 1024, 1024}; pg8::StaticOrder So; So.init(S_, 1024, Fp.G, (int)blockIdx.x);
            pg8::EpiResid<true> E{L_XSRC, xout, 1024, L_MOD + 2048, P_BF(WS_XB), (u64*)(wsl + WS_SS)};
            pg8::gemm_phase<pg8::EpiResid<true>, pg8::StaticOrder, true, true>(Fp.lds, g, So, E, Fp.wave);
            SEAM(pb + 9);
          }
        }
        if (IN(pb + 10) && (PHMASK >> 10 & 1)) { FRESH(Fp);
          _Pragma("unroll 1") for (int rep_ = 0; rep_ < 1 + ((REPMASK >> 10) & 1); ++rep_) {
            pg8::Gemm g{P_BF(WS_XB), (const bf16*)(L_WL + W_F1), S_, DFF_, 1024, 1024, 1024}; pg8::StaticOrder So; So.init(S_, DFF_, Fp.G, (int)blockIdx.x);
            pg8::EpiRelu2 E{P_BF(WS_FFU), DFF_, (u64*)(wsl + WS_SS), P_F32(WS_B1F)};
            pg8::gemm_phase<pg8::EpiRelu2, pg8::StaticOrder, true, true>(Fp.lds, g, So, E, Fp.wave);
            SEAM(pb + 10);
          }
        }
        if (IN(pb + 11) && (PHMASK >> 11 & 1)) { FRESH(Fp);
          _Pragma("unroll 1") for (int rep_ = 0; rep_ < 1 + ((REPMASK >> 11) & 1); ++rep_) {
            pg8::Gemm g{P_BF(WS_FFU), (const bf16*)(L_WL + W_F2), S_, 1024, DFF_, DFF_, DFF_}; pg8::StaticOrder So; So.init(S_, 1024, Fp.G, (int)blockIdx.x);
            pg8::EpiResid<false> E{xout, xout, 1024, L_MOD + 5120, nullptr, nullptr};
            pg8::gemm_phase<pg8::EpiResid<false>, pg8::StaticOrder, true, true>(Fp.lds, g, So, E, Fp.wave);
            SEAM(pb + 11);
          }
        }
    }
#undef IN
#undef SEAM
}

#ifndef MK_ONE_LAUNCH
#define MK_ONE_LAUNCH 1
#endif
extern "C" void kernel_launch(void* const* d_in, const int* in_sizes, int n_in, void* d_out, int out_size, void* d_ws, size_t ws_size, hipStream_t stream) {
    constexpr int grid = 256;
    static int once = 0;
    if (!once) { once = 1; (void)hipFuncSetAttribute((const void*)fwd, hipFuncAttributeMaxDynamicSharedMemorySize, LDS_BYTES); }
    if (ws_size < WS_END || n_in != 22) return;
    (void)hipMemsetAsync((char*)d_ws + WS_CTL, 0, CTL_ZERO_BYTES, stream);
    Args a{};
    for (int i = 0; i < 22; ++i) a.in[i] = (const float*)d_in[i];
    a.out = (float*)d_out; a.ws = (unsigned char*)d_ws;
#if MK_ONE_LAUNCH
    a.ph_lo = 0; a.ph_hi = NPHASES;
    hipLaunchKernelGGL(fwd, dim3(grid), dim3(512), LDS_BYTES, stream, a);
#else
    for (int p = 0; p < NPHASES; ++p) { a.ph_lo = p; a.ph_hi = p + 1; hipLaunchKernelGGL(fwd, dim3(grid), dim3(512), LDS_BYTES, stream, a); }
#endif
}
```

```cpp
#include <hip/hip_runtime.h>
#include <cstdio>
#include <cstdint>
#include <cmath>

constexpr int S_ = 16384, DM_ = 1024, DEPTH_ = 4, NIN_SRC = 9224, NIN_ = 9216, GATE_COL = 7168, DFF_ = 4096;
constexpr float EPS_ = 1e-6f;
constexpr float LOG2E_ = 1.4426950408889634f;
constexpr float C2Q_ = 0.125f * 1.4426950408889634f;

constexpr size_t EP_Q = 80u << 20, EP_K = 112u << 20, EP_V8T = 128u << 20, EP_V = 144u << 20, EP_MQKR = 176u << 20, EP_MV = 240u << 20, EP_MO = 272u << 20, EP_GAM = 304u << 20;

#ifndef DBG_ATT_SCALE
#define DBG_ATT_SCALE 1.0f
#endif
#ifndef DBG_MLS_SCALE
#define DBG_MLS_SCALE 1.0f
#endif
__device__ __forceinline__ int lane_id_opaque() { int l; asm volatile("v_mbcnt_lo_u32_b32 %0, -1, 0\n\tv_mbcnt_hi_u32_b32 %0, -1, %0" : "=v"(l)); return l; }
template <int M> __device__ __forceinline__ float swz_xor(float v) { static_assert(M >= 1 && M < 32, "xor inside a 32-lane half"); return __uint_as_float((unsigned)__builtin_amdgcn_ds_swizzle((int)__float_as_uint(v), (M << 10) | 0x1f)); }
__device__ __forceinline__ void halves(float v, float& lo, float& hi) { auto rr = __builtin_amdgcn_permlane32_swap(__float_as_uint(v), __float_as_uint(v), false, false); lo = __uint_as_float(rr[0]); hi = __uint_as_float(rr[1]); }
__device__ __forceinline__ float bperm(float v, int src_lane) { return __uint_as_float((unsigned)__builtin_amdgcn_ds_bpermute(src_lane << 2, (int)__float_as_uint(v))); }
typedef unsigned long long u64;
constexpr float SSQ_ = 16777216.0f, B1Q_ = 4294967296.0f;
__device__ __forceinline__ u64 zero64_opaque() { unsigned z = 0u; asm volatile("" : "+v"(z)); return ((u64)z << 32) | z; }
__device__ __forceinline__ u64 fx_enc(float v, float q) { return (u64)(long long)(v * q); }
__device__ __forceinline__ float fx_dec(u64 v, float iq) { return (float)(long long)v * iq; }
__device__ __forceinline__ float fx_dec_ss(u64 v) { return (float)(unsigned)(v >> 32) * 256.0f + (float)(unsigned)v * (1.0f / SSQ_); }
#ifndef PROJ8
#define PROJ8 1
#endif
#ifndef P8_LO
#define P8_LO 12
#endif
#ifndef P8_HI
#define P8_HI 12
#endif
constexpr unsigned long long PROJ8_TILES = PROJ8 ? (((1ull << 36) - 1) & ~(((1ull << P8_HI) - 1) & ~((1ull << P8_LO) - 1))) : 0ull;
#ifndef EMU8
#define EMU8 0
#endif
__device__ __forceinline__ float r8f(float x, float s) { const int w = __builtin_amdgcn_cvt_pk_fp8_f32(x * s, 0.f, 0, false); return __builtin_amdgcn_cvt_f32_fp8(w, 0) * (1.0f / s); }

namespace pg8 {
#define PG8_LAS __attribute__((address_space(3)))
typedef unsigned short bf16_t;
typedef short bf16x8 __attribute__((ext_vector_type(8)));
typedef float f32x4 __attribute__((ext_vector_type(4)));
typedef unsigned u32x4 __attribute__((ext_vector_type(4)));
typedef int i32x8g __attribute__((ext_vector_type(8)));
typedef int i32x4g __attribute__((ext_vector_type(4)));
constexpr int BM = 256, BK = 64, HALF = 128, HTB = HALF * BK * 2  , STAGE_BYTES = 8 * HTB, NXCD = 8, WGM = 8;

__host__ __device__ __forceinline__ int lds_byte(int r, int c) { const int st = (r >> 4) * 2 + (c >> 5), rr = r & 15, cc = c & 31, ob = rr * 64 + cc * 2; return st * 1024 + (ob ^ (((ob >> 9) & 1) << 5)); }
__host__ __device__ __forceinline__ void stage_rc(int b, int& R, int& C) { const int st = b / 1024, sb = b % 1024, swz = sb ^ (((sb >> 9) & 1) << 5); R = (st >> 1) * 16 + swz / 64; C = (st & 1) * 32 + (swz % 64) / 2; }
__host__ __device__ __forceinline__ int perm32(int rho) { const int n = rho >> 4, i = rho & 15; return 8 * (i >> 2) + 4 * n + (i & 3); }

struct Unit { int pm, pn; };
struct Gemm { const bf16_t* A; const bf16_t* Bt; int M, N, K, lda, ldb; };

struct StaticOrder {
    int nM, nN, nwg, G, c;
    __host__ __device__ void init(int M, int N, int G_, int c_) { nM = M / BM; nN = N / BM; nwg = nM * nN; G = G_; c = c_; }
    __host__ __device__ bool next(int i, Unit& u) const {
        const long L = (long)i * G + c; if (L >= nwg) return false;
        int wgid = (int)L; { const int q = nwg / NXCD, r = nwg % NXCD, xcd = wgid % NXCD, off = wgid / NXCD; wgid = (xcd < r ? xcd * (q + 1) : r * (q + 1) + (xcd - r) * q) + off; }
        const int nig = WGM * nN, gid = wgid / nig, fm = gid * WGM, gsz = (nM - fm) < WGM ? (nM - fm) : WGM;
        u.pm = fm + ((wgid % nig) % gsz); u.pn = (wgid % nig) / gsz; return true;
    }
    __device__ __forceinline__ void a_ready(const Unit&) const {}
    __device__ __forceinline__ void done(const Unit&) const {}
};
template <int SPLIT, int SKIP> struct SubsetOrder : StaticOrder {
    __host__ __device__ bool next(int i, Unit& u) const { if (!StaticOrder::next(i, u)) return false; if (u.pn >= SPLIT) u.pn += SKIP; return true; }
};

__device__ __forceinline__ unsigned cvt_pk_bf16(float lo, float hi) { unsigned r; asm volatile("v_cvt_pk_bf16_f32 %0, %1, %2" : "=v"(r) : "v"(lo), "v"(hi)); return r; }
__device__ __forceinline__ float sigm(float x) { return __builtin_amdgcn_rcpf(1.0f + __expf(-x)); }
__device__ __forceinline__ float bflo(unsigned w) { return __uint_as_float(w << 16); }
__device__ __forceinline__ float bfhi(unsigned w) { return __uint_as_float(w & 0xffff0000u); }
__device__ __forceinline__ u32x4 pack8(const f32x4 v0, const f32x4 v1) { u32x4 w; w.x = cvt_pk_bf16(v0[0], v0[1]); w.y = cvt_pk_bf16(v0[2], v0[3]); w.z = cvt_pk_bf16(v1[0], v1[1]); w.w = cvt_pk_bf16(v1[2], v1[3]); return w; }

struct EpiProj {
    static constexpr bool PERM = true, AFTER_DRAIN = false, MIDK = false;
    unsigned char* ws; const float *qg, *kg;
    __device__ __forceinline__ void operator()(const f32x4 (&acc)[2][2][4][2], const Unit& u, int wr, int wc, int fr_in, int fq_in) const {
        int fr = fr_in, fq = fq_in; asm volatile("" : "+v"(fr), "+v"(fq));
        const int pn = u.pn; const int row0 = u.pm * BM + wr * 64 + fr;
        if (pn < 8) {
            const bool isq = pn < 4; const float* g = isq ? qg : kg; const float sc = isq ? 8.0f * C2Q_ : 1.0f;
            f32x4 gv[2][2];
#pragma unroll
            for (int bj = 0; bj < 2; ++bj)
#pragma unroll
                for (int n = 0; n < 2; ++n) gv[bj][n] = *(const f32x4*)(g + 32 * bj + 8 * fq + 4 * n);
            unsigned char* qbase = ws + EP_Q + (pn & 3) * 256 + 64 * wc + 8 * fq;
            unsigned char* kbase = ws + EP_K + (pn & 3) * 256 + 64 * wc + (fq & 1) * 32 + (fq >> 1) * 8;
#pragma unroll
            for (int ai = 0; ai < 2; ++ai)
#pragma unroll
                for (int m = 0; m < 4; ++m) {
                    float ss = 0.f;
#pragma unroll
                    for (int bj = 0; bj < 2; ++bj)
#pragma unroll
                        for (int n = 0; n < 2; ++n) { const f32x4 x = acc[ai][bj][m][n]; ss += (x[0] * x[0] + x[1] * x[1]) + (x[2] * x[2] + x[3] * x[3]); }
                    ss += swz_xor<16>(ss); { float lo_, hi_; halves(ss, lo_, hi_); ss = lo_ + hi_; }
                    const float r = sc / sqrtf(ss * (1.0f / 64.0f) + EPS_);
                    const size_t row = (size_t)(row0 + ai * HALF + m * 16);
#pragma unroll
                    for (int bj = 0; bj < 2; ++bj) { const f32x4 v0 = acc[ai][bj][m][0] * r * gv[bj][0], v1 = acc[ai][bj][m][1] * r * gv[bj][1];
                        int lo = 0, hi4 = 0; lo = __builtin_amdgcn_cvt_pk_fp8_f32(v0[0], v0[1], lo, false); lo = __builtin_amdgcn_cvt_pk_fp8_f32(v0[2], v0[3], lo, true);
                        hi4 = __builtin_amdgcn_cvt_pk_fp8_f32(v1[0], v1[1], hi4, false); hi4 = __builtin_amdgcn_cvt_pk_fp8_f32(v1[2], v1[3], hi4, true);
                        typedef int i32x2 __attribute__((ext_vector_type(2)));
                        if (isq) *(i32x2*)(qbase + row * 1024 + 32 * bj) = (i32x2){lo, hi4}; else *(i32x2*)(kbase + row * 1024 + 16 * bj) = (i32x2){lo, hi4}; }
                }
        } else if (pn < 12) {
            const int a = (fr >> 2) & 3, j = fr & 3;
            const unsigned selj = 0x0c0c0000u | ((4u + (unsigned)j) << 8) | (unsigned)j;
            unsigned char* vb = ws + EP_V8T + ((size_t)(2 * (pn - 8)) * 256 + (size_t)(u.pm * 4 + wr)) * 8192 + (size_t)(wc * 32 + 8 * fq + j) * 64 + (a & 1) * 32 + (a >> 1) * 4;
#pragma unroll
            for (int ai = 0; ai < 2; ++ai)
#pragma unroll
                for (int m = 0; m < 4; ++m)
#pragma unroll
                    for (int bj = 0; bj < 2; ++bj)
#pragma unroll
                        for (int n = 0; n < 2; ++n) { const f32x4 x = acc[ai][bj][m][n];
                            int w = __builtin_amdgcn_cvt_pk_fp8_f32(x[0], x[1], 0, false); w = __builtin_amdgcn_cvt_pk_fp8_f32(x[2], x[3], w, true);
                            const int l0 = __builtin_amdgcn_mov_dpp(w, 0x00, 0xf, 0xf, true), l1 = __builtin_amdgcn_mov_dpp(w, 0x55, 0xf, 0xf, true), l2 = __builtin_amdgcn_mov_dpp(w, 0xaa, 0xf, 0xf, true), l3 = __builtin_amdgcn_mov_dpp(w, 0xff, 0xf, 0xf, true);
                            const unsigned t01 = __builtin_amdgcn_perm((unsigned)l1, (unsigned)l0, selj), t23 = __builtin_amdgcn_perm((unsigned)l3, (unsigned)l2, selj);
                            const unsigned tt = __builtin_amdgcn_perm(t23, t01, 0x05040100u);
                            *(unsigned*)(vb + ((size_t)bj * 256 + (size_t)ai * 2) * 8192 + (size_t)(4 * n) * 64 + (m >> 1) * 16 + (m & 1) * 8) = tt; }
        } else {
            bf16_t* base; int ldc, c0; bool sg;
            if (pn < 20) { base = (bf16_t*)(ws + EP_MQKR); ldc = 2048; c0 = (pn - 12) * 256; sg = false; }
            else if (pn < 24) { base = (bf16_t*)(ws + EP_MV); ldc = 1024; c0 = (pn - 20) * 256; sg = false; }
            else if (pn < 28) { base = (bf16_t*)(ws + EP_MO); ldc = 1024; c0 = (pn - 24) * 256; sg = true; }
            else { base = (bf16_t*)(ws + EP_GAM); ldc = 2048; c0 = (pn - 28) * 256; sg = true; }
            const int col0 = c0 + wc * 32 + 8 * fq;
#pragma unroll
            for (int ai = 0; ai < 2; ++ai)
#pragma unroll
                for (int m = 0; m < 4; ++m) { bf16_t* rowp = base + (size_t)(row0 + ai * HALF + m * 16) * ldc + col0;
#pragma unroll
                    for (int bj = 0; bj < 2; ++bj) { f32x4 v0 = acc[ai][bj][m][0], v1 = acc[ai][bj][m][1];
                        if (sg) {
#pragma unroll
                            for (int i = 0; i < 4; ++i) { v0[i] = sigm(v0[i]); v1[i] = sigm(v1[i]); } }
                        *(u32x4*)(rowp + bj * HALF) = pack8(v0, v1); } }
        }
    }
};
struct EpiRelu2 {
    static constexpr bool PERM = true, AFTER_DRAIN = false, MIDK = false;
    bf16_t* O; int ldc; const u64* SS; const float* b1;
    __device__ __forceinline__ void operator()(const f32x4 (&acc)[2][2][4][2], const Unit& u, int wr, int wc, int fr, int fq) const {
        const int row0 = u.pm * BM + wr * 64 + fr, col0 = u.pn * BM + wc * 32 + 8 * fq;
        f32x4 bv[2][2];
#pragma unroll
        for (int bj = 0; bj < 2; ++bj)
#pragma unroll
            for (int n = 0; n < 2; ++n) bv[bj][n] = *(const f32x4*)(b1 + col0 + bj * HALF + 4 * n);
#pragma unroll
        for (int ai = 0; ai < 2; ++ai)
#pragma unroll
            for (int m = 0; m < 4; ++m) { const int row = row0 + ai * HALF + m * 16; const float r = __builtin_amdgcn_rsqf(fx_dec_ss(SS[row]) * (1.0f / 1024.0f) + EPS_);
                bf16_t* rowp = O + (size_t)row * ldc + col0;
#pragma unroll
                for (int bj = 0; bj < 2; ++bj) { f32x4 v0 = acc[ai][bj][m][0] * r + bv[bj][0], v1 = acc[ai][bj][m][1] * r + bv[bj][1];
#pragma unroll
                    for (int i = 0; i < 4; ++i) { const float a = fmaxf(v0[i], 0.f), b = fmaxf(v1[i], 0.f); v0[i] = a * a; v1[i] = b * b; if (EMU8 & 4) { v0[i] = r8f(v0[i], 1.f); v1[i] = r8f(v1[i], 1.f); } }
                    *(u32x4*)(rowp + bj * HALF) = pack8(v0, v1); } }
    }
};
struct EpiMerge {
    static constexpr bool PERM = true, AFTER_DRAIN = false, MIDK = true;
    bf16_t* O; int ldc; const bf16_t* G; int ldg;
    static __device__ __forceinline__ float g2c(float g) { return fmaxf(g, 9.094947e-13f); }
    __device__ __forceinline__ void mid(f32x4 (&acc)[2][2][4][2], const Unit& u, int wr, int wc, int fr, int fq) const {
        const int row0 = u.pm * BM + wr * 64 + fr, col0 = u.pn * BM + wc * 32 + 8 * fq;
#pragma unroll
        for (int g = 0; g < 8; ++g) { const int ai = g >> 2, m = g & 3; const size_t r = (size_t)(row0 + ai * HALF + m * 16);
#pragma unroll
            for (int bj = 0; bj < 2; ++bj) { const u32x4 q1 = *(const u32x4*)(G + r * ldg + col0 + bj * HALF), q2 = *(const u32x4*)(G + r * ldg + 1024 + col0 + bj * HALF);
                f32x4& v0 = acc[ai][bj][m][0]; f32x4& v1 = acc[ai][bj][m][1];
                v0[0] *= bflo(q1.x) * __builtin_amdgcn_rcpf(g2c(bflo(q2.x))); v0[1] *= bfhi(q1.x) * __builtin_amdgcn_rcpf(g2c(bfhi(q2.x))); v0[2] *= bflo(q1.y) * __builtin_amdgcn_rcpf(g2c(bflo(q2.y))); v0[3] *= bfhi(q1.y) * __builtin_amdgcn_rcpf(g2c(bfhi(q2.y)));
                v1[0] *= bflo(q1.z) * __builtin_amdgcn_rcpf(g2c(bflo(q2.z))); v1[1] *= bfhi(q1.z) * __builtin_amdgcn_rcpf(g2c(bfhi(q2.z))); v1[2] *= bflo(q1.w) * __builtin_amdgcn_rcpf(g2c(bflo(q2.w))); v1[3] *= bfhi(q1.w) * __builtin_amdgcn_rcpf(g2c(bfhi(q2.w))); } }
    }
    __device__ __forceinline__ void operator()(const f32x4 (&acc)[2][2][4][2], const Unit& u, int wr, int wc, int fr, int fq) const {
        const int row0 = u.pm * BM + wr * 64 + fr, col0 = u.pn * BM + wc * 32 + 8 * fq;
        u32x4 gw[2][2];
#define EG_LOAD(g_, b_) do { const size_t r_ = (size_t)(row0 + ((g_) >> 2) * HALF + ((g_) & 3) * 16); _Pragma("unroll") for (int bj = 0; bj < 2; ++bj) gw[b_][bj] = *(const u32x4*)(G + r_ * ldg + 1024 + col0 + bj * HALF); } while (0)
        EG_LOAD(0, 0);
#pragma unroll
        for (int g = 0; g < 8; ++g) { const int ai = g >> 2, m = g & 3, b = g & 1; const size_t r = (size_t)(row0 + ai * HALF + m * 16);
            if (g + 1 < 8) EG_LOAD(g + 1, (g + 1) & 1);
#pragma unroll
            for (int bj = 0; bj < 2; ++bj) { f32x4 v0 = acc[ai][bj][m][0], v1 = acc[ai][bj][m][1]; const u32x4 q = gw[b][bj];
                v0[0] *= g2c(bflo(q.x)); v0[1] *= g2c(bfhi(q.x)); v0[2] *= g2c(bflo(q.y)); v0[3] *= g2c(bfhi(q.y)); v1[0] *= g2c(bflo(q.z)); v1[1] *= g2c(bfhi(q.z)); v1[2] *= g2c(bflo(q.w)); v1[3] *= g2c(bfhi(q.w));
                *(u32x4*)(O + r * ldc + col0 + bj * HALF) = pack8(v0, v1); } }
#undef EG_LOAD
    }
};
template <bool STAT> struct EpiResid {
    static constexpr bool PERM = false, AFTER_DRAIN = false, MIDK = false;
    const float* xin; float* out; int ldc; const float* gate; bf16_t* XB; u64* SS;
    __device__ __forceinline__ void operator()(const f32x4 (&acc)[2][2][4][2], const Unit& u, int wr, int wc, int fr, int fq) const {
        const int row0 = u.pm * BM + wr * 64 + fr, col0 = u.pn * BM + wc * 32 + 4 * fq;
        f32x4 gv[2][2];
#pragma unroll
        for (int bj = 0; bj < 2; ++bj)
#pragma unroll
            for (int n = 0; n < 2; ++n) gv[bj][n] = *(const f32x4*)(gate + col0 + bj * HALF + n * 16);
        f32x4 xa[2][2][2];
#define ER_LOAD(g_, b_) do { const size_t o_ = (size_t)(row0 + ((g_) >> 2) * HALF + ((g_) & 3) * 16) * ldc + col0; _Pragma("unroll") for (int bj = 0; bj < 2; ++bj) _Pragma("unroll") for (int n = 0; n < 2; ++n) xa[b_][bj][n] = *(const f32x4*)(xin + o_ + bj * HALF + n * 16); } while (0)
        ER_LOAD(0, 0);
#pragma unroll
        for (int g = 0; g < 8; ++g) { const int ai = g >> 2, m = g & 3, b = g & 1; const int row = row0 + ai * HALF + m * 16; const size_t off = (size_t)row * ldc + col0; float ss = 0.f;
            if (g + 1 < 8) ER_LOAD(g + 1, (g + 1) & 1);
#pragma unroll
            for (int bj = 0; bj < 2; ++bj)
#pragma unroll
                for (int n = 0; n < 2; ++n) { const f32x4 y = xa[b][bj][n] + gv[bj][n] * acc[ai][bj][m][n];
                    *(f32x4*)(out + off + bj * HALF + n * 16) = y;
                    if (STAT) { ss += (y[0] * y[0] + y[1] * y[1]) + (y[2] * y[2] + y[3] * y[3]);
                        typedef unsigned u32x2 __attribute__((ext_vector_type(2))); u32x2 w; f32x4 yq = y; if (EMU8 & 2) { yq[0] = r8f(y[0], 1.f); yq[1] = r8f(y[1], 1.f); yq[2] = r8f(y[2], 1.f); yq[3] = r8f(y[3], 1.f); } w.x = cvt_pk_bf16(yq[0], yq[1]); w.y = cvt_pk_bf16(yq[2], yq[3]); *(u32x2*)(XB + off + bj * HALF + n * 16) = w; } }
            if (STAT) { ss += swz_xor<16>(ss); float lo_, hi_; halves(ss, lo_, hi_); ss = lo_ + hi_; if (fq == 0) atomicAdd(SS + row, fx_enc(ss, SSQ_)); } }
#undef ER_LOAD
    }
};

template <class Epi, class Sched, bool ALIGN_EPI = false, bool SP2 = false, bool F8 = false>
__device__ __forceinline__ void gemm_phase(PG8_LAS unsigned char* lds, const Gemm g, const Sched& S, const Epi& E, const int wid_in) {
    const int lane = lane_id_opaque(), wid = wid_in, tid = wid * 64 + lane;
    const int wr = wid >> 2, wc = wid & 3, fr = lane & 15, fq = lane >> 4;
    const int K = g.K, nt = K / BK;
    unsigned voffA, voffB;
    { int R, C; stage_rc(tid * 16, R, C); const int Rb = Epi::PERM ? ((R & ~31) + perm32(R & 31)) : R;
      voffA = (unsigned)(R * g.lda + C) * 2u; voffB = (unsigned)(Rb * g.ldb + C) * 2u; }
    const size_t d64A = (size_t)64 * g.lda * 2, d64B = (size_t)64 * g.ldb * 2;
    const size_t kstep = (size_t)(BK * 2);
    const size_t hstepA = (size_t)HALF * g.lda * 2, hstepB = (size_t)HALF * g.ldb * 2;
    const size_t tstepA = 2 * hstepA, tstepB = 2 * hstepB;
    const unsigned ldsw = (unsigned)wid * 1024u;
    const int aoff = lds_byte(wr * 64 + fr, fq * 8), boff = lds_byte(wc * 32 + fr, fq * 8);
#define PG8_SA(b, h) (((b) * 2 + (h)) * HTB)
#define PG8_SB(b, h) ((4 + (b) * 2 + (h)) * HTB)
#define PG8_STAGE(bufoff, gbase, voff) do { \
        __builtin_amdgcn_global_load_lds((const unsigned*)((const char*)(gbase) + (voff)), (PG8_LAS unsigned*)(lds + (bufoff) + ldsw), 16, 0, 0); \
        __builtin_amdgcn_global_load_lds((const unsigned*)((const char*)(gbase) + PG8_D64(voff) + (voff)), (PG8_LAS unsigned*)(lds + (bufoff) + ldsw + 8192), 16, 0, 0); } while (0)
#define PG8_D64(voff) PG8_D64_##voff
#define PG8_D64_voffA d64A
#define PG8_D64_voffB d64B
#define PG8_LD32(p) __builtin_shufflevector(*(const PG8_LAS i32x4g*)(p), *(const PG8_LAS i32x4g*)((p) + 1024), 0, 1, 2, 3, 4, 5, 6, 7)
#define PG8_LO(v) __builtin_bit_cast(bf16x8, __builtin_shufflevector(v, v, 0, 1, 2, 3))
#define PG8_HI(v) __builtin_bit_cast(bf16x8, __builtin_shufflevector(v, v, 4, 5, 6, 7))
#define PG8_LDA(dst, b, h) do { _Pragma("unroll") for (int m = 0; m < 4; ++m) dst[m] = PG8_LD32(lds + PG8_SA(b, h) + aoff + m * 2048); } while (0)
#define PG8_LDB(dst, b, h) do { _Pragma("unroll") for (int n = 0; n < 2; ++n) dst[n] = PG8_LD32(lds + PG8_SB(b, h) + boff + n * 2048); } while (0)
#define PG8_MMA(ai, bj, At, Bt) do { __builtin_amdgcn_s_setprio(1); _Pragma("unroll") for (int m = 0; m < 4; ++m) _Pragma("unroll") for (int n = 0; n < 2; ++n) { \
        if constexpr (F8) asm volatile("v_mfma_scale_f32_16x16x128_f8f6f4 %0, %1, %2, %0, %3, %3 op_sel_hi:[0,0,0]" : "+v"(acc[ai][bj][m][n]) : "v"(Bt[n]), "v"(At[m]), "v"(sc8)); \
        else { acc[ai][bj][m][n] = __builtin_amdgcn_mfma_f32_16x16x32_bf16(PG8_LO(Bt[n]), PG8_LO(At[m]), acc[ai][bj][m][n], 0, 0, 0); \
               acc[ai][bj][m][n] = __builtin_amdgcn_mfma_f32_16x16x32_bf16(PG8_HI(Bt[n]), PG8_HI(At[m]), acc[ai][bj][m][n], 0, 0, 0); } } __builtin_amdgcn_s_setprio(0); } while (0)
#define PG8_WAIT_V(n) asm volatile("s_waitcnt vmcnt(" #n ")" ::: "memory")
#define PG8_WAIT_L(n) asm volatile("s_waitcnt lgkmcnt(" #n ")" ::: "memory")
#define PG8_BAR __builtin_amdgcn_s_barrier()
#define PG8_SCHED __builtin_amdgcn_sched_barrier(0)
    Unit cur, nxt; int ui = 0;
    if (!S.next(0, cur)) return;
    f32x4 acc[2][2][4][2];
#pragma unroll
    for (int a = 0; a < 2; ++a)
#pragma unroll
        for (int b = 0; b < 2; ++b)
#pragma unroll
            for (int m = 0; m < 4; ++m)
#pragma unroll
                for (int n = 0; n < 2; ++n) acc[a][b][m][n] = (f32x4){0.f, 0.f, 0.f, 0.f};
    i32x8g At[4], B0[2], B1[2];
    int sc8 = 0x7c; asm volatile("" : "+v"(sc8));
    const char* cA = (const char*)g.A + (size_t)cur.pm * tstepA; const char* cB = (const char*)g.Bt + (size_t)cur.pn * tstepB;
    S.a_ready(cur);
    if constexpr (SP2) {
        PG8_STAGE(PG8_SB(0, 0), cB, voffB); PG8_STAGE(PG8_SB(0, 1), cB + hstepB, voffB); PG8_STAGE(PG8_SA(0, 0), cA, voffA); PG8_STAGE(PG8_SA(0, 1), cA + hstepA, voffA);
        PG8_STAGE(PG8_SB(1, 0), cB + kstep, voffB); PG8_STAGE(PG8_SA(1, 0), cA + kstep, voffA); PG8_STAGE(PG8_SB(1, 1), cB + hstepB + kstep, voffB);
        if (wr == 1) PG8_BAR;
        PG8_WAIT_V(8); PG8_BAR;
        PG8_WAIT_V(6); PG8_BAR;
    } else {
        PG8_STAGE(PG8_SB(0, 0), cB, voffB); PG8_STAGE(PG8_SA(0, 0), cA, voffA); PG8_STAGE(PG8_SB(0, 1), cB + hstepB, voffB); PG8_STAGE(PG8_SA(0, 1), cA + hstepA, voffA);
        if (wr == 1) PG8_BAR;
        PG8_WAIT_V(4); PG8_BAR;
        PG8_STAGE(PG8_SB(1, 0), cB + kstep, voffB); PG8_STAGE(PG8_SA(1, 0), cA + kstep, voffA); PG8_STAGE(PG8_SB(1, 1), cB + hstepB + kstep, voffB);
        PG8_WAIT_V(6); PG8_BAR;
    }
    for (;;) {
        const bool has_next = S.next(ui + 1, nxt);
        const char* nA = has_next ? (const char*)g.A + (size_t)nxt.pm * tstepA : cA; const char* nB = has_next ? (const char*)g.Bt + (size_t)nxt.pn * tstepB : cB;
#pragma unroll 1
        for (int t = 0; t < nt; t += 2) {
            if constexpr (Epi::MIDK) { if (t == nt / 2) { const int lm = lane_id_opaque(); E.mid(acc, cur, wr, wc, lm & 15, lm >> 4); } }
            const bool last = (t == nt - 2);
            const char* a1 = cA + (size_t)(t + 1) * kstep;
            const char* a2 = last ? nA : cA + (size_t)(t + 2) * kstep; const char* b2 = last ? nB : cB + (size_t)(t + 2) * kstep;
            const char* a3 = a2 + kstep; const char* b3 = b2 + kstep;
            if (last && has_next) S.a_ready(nxt);
            if constexpr (SP2) {
            PG8_LDB(B0, 0, 0); PG8_LDB(B1, 0, 1); PG8_SCHED; PG8_LDA(At, 0, 0); PG8_STAGE(PG8_SA(1, 1), a1 + hstepA, voffA);
            PG8_WAIT_V(8); PG8_WAIT_L(0); PG8_BAR; PG8_MMA(0, 0, At, B0); PG8_MMA(0, 1, At, B1); PG8_BAR; PG8_SCHED;
            PG8_LDA(At, 0, 1); PG8_STAGE(PG8_SB(0, 0), b2, voffB); PG8_STAGE(PG8_SB(0, 1), b2 + hstepB, voffB); PG8_STAGE(PG8_SA(0, 0), a2, voffA);
            PG8_WAIT_V(8); PG8_WAIT_L(0); PG8_BAR; PG8_MMA(1, 0, At, B0); PG8_MMA(1, 1, At, B1); PG8_BAR; PG8_SCHED;
            PG8_LDB(B0, 1, 0); PG8_LDB(B1, 1, 1); PG8_SCHED; PG8_LDA(At, 1, 0); PG8_STAGE(PG8_SA(0, 1), a2 + hstepA, voffA);
            PG8_WAIT_V(8); PG8_WAIT_L(0); PG8_BAR; PG8_MMA(0, 0, At, B0); PG8_MMA(0, 1, At, B1); PG8_BAR; PG8_SCHED;
            PG8_LDA(At, 1, 1); PG8_STAGE(PG8_SB(1, 0), b3, voffB); PG8_STAGE(PG8_SB(1, 1), b3 + hstepB, voffB); PG8_STAGE(PG8_SA(1, 0), a3, voffA);
            PG8_WAIT_V(8); PG8_WAIT_L(0); PG8_BAR; PG8_MMA(1, 0, At, B0); PG8_MMA(1, 1, At, B1); PG8_BAR; PG8_SCHED;
            } else {
            PG8_LDB(B0, 0, 0); PG8_SCHED; PG8_LDA(At, 0, 0); PG8_STAGE(PG8_SA(1, 1), a1 + hstepA, voffA);
            PG8_WAIT_L(8); PG8_BAR; PG8_WAIT_L(0); PG8_MMA(0, 0, At, B0); PG8_BAR; PG8_SCHED;
            PG8_LDB(B1, 0, 1); PG8_STAGE(PG8_SB(0, 0), b2, voffB);
            PG8_BAR; PG8_WAIT_L(0); PG8_MMA(0, 1, At, B1); PG8_BAR;
            PG8_LDA(At, 0, 1); PG8_STAGE(PG8_SA(0, 0), a2, voffA);
            PG8_BAR; PG8_WAIT_L(0); PG8_MMA(1, 0, At, B0); PG8_BAR; PG8_SCHED;
            PG8_STAGE(PG8_SB(0, 1), b2 + hstepB, voffB);
            PG8_WAIT_V(6); PG8_BAR; PG8_MMA(1, 1, At, B1); PG8_BAR;
            PG8_LDB(B0, 1, 0); PG8_SCHED; PG8_LDA(At, 1, 0); PG8_STAGE(PG8_SA(0, 1), a2 + hstepA, voffA);
            PG8_WAIT_L(8); PG8_BAR; PG8_WAIT_L(0); PG8_MMA(0, 0, At, B0); PG8_BAR; PG8_SCHED;
            PG8_LDB(B1, 1, 1); PG8_STAGE(PG8_SB(1, 0), b3, voffB);
            PG8_BAR; PG8_WAIT_L(0); PG8_MMA(0, 1, At, B1); PG8_BAR;
            PG8_LDA(At, 1, 1); PG8_STAGE(PG8_SA(1, 0), a3, voffA);
            PG8_BAR; PG8_WAIT_L(0); PG8_MMA(1, 0, At, B0); PG8_BAR; PG8_SCHED;
            PG8_STAGE(PG8_SB(1, 1), b3 + hstepB, voffB);
            PG8_WAIT_V(6); PG8_BAR; PG8_MMA(1, 1, At, B1); PG8_BAR;
            }
        }
        if constexpr (F8) asm volatile("s_nop 15\n\ts_nop 15" ::: "memory");
        if constexpr (ALIGN_EPI) { if (wr == 0) PG8_BAR; }
        if constexpr (!Epi::AFTER_DRAIN) { const int le = lane_id_opaque(); E(acc, cur, wr, wc, le & 15, le >> 4); S.done(cur); }
        if (!has_next) break;
#pragma unroll
        for (int a = 0; a < 2; ++a)
#pragma unroll
            for (int b = 0; b < 2; ++b)
#pragma unroll
                for (int m = 0; m < 4; ++m)
#pragma unroll
                    for (int n = 0; n < 2; ++n) acc[a][b][m][n] = (f32x4){0.f, 0.f, 0.f, 0.f};
        cur = nxt; cA = nA; cB = nB; ++ui;
        if constexpr (ALIGN_EPI) { if (wr == 1) PG8_BAR; }
    }
    PG8_WAIT_V(0);
    if constexpr (!ALIGN_EPI) { if (wr == 0) PG8_BAR; }
    PG8_BAR;
    if constexpr (Epi::AFTER_DRAIN) { E.fused(acc, cur, wr, wc, fr, fq, lds, wid, lane); S.done(cur); }
#undef PG8_SA
#undef PG8_SB
#undef PG8_STAGE
#undef PG8_D64
#undef PG8_D64_voffA
#undef PG8_D64_voffB
#undef PG8_LDA
#undef PG8_LDB
#undef PG8_MMA
#undef PG8_LD32
#undef PG8_LO
#undef PG8_HI
#undef PG8_WAIT_V
#undef PG8_WAIT_L
#undef PG8_BAR
#undef PG8_SCHED
}
}

constexpr size_t MiB = 1u << 20;
constexpr size_t WS_CTL = 0, CTL_ZERO_BYTES = 64 * 1024;
constexpr size_t WS_MODP = 1 * MiB;
constexpr size_t WS_MOD = 3 * MiB;
constexpr size_t WS_TAB = 3 * MiB + 512 * 1024;
constexpr size_t WS_IG = 4 * MiB;
constexpr size_t WS_LF = WS_IG + 256 * 1024, WS_BC = WS_LF + 256 * 1024, WS_AA = WS_BC + 256 * 1024;
constexpr size_t WS_CHK = 5 * MiB;
constexpr size_t WS_BL = WS_CHK, WS_ML = WS_CHK + 4096, WS_MP = WS_CHK + 8192;
constexpr size_t WS_NU = 5 * MiB + 64 * 1024;
constexpr size_t WS_NST = WS_NU + 512 * 1024;
constexpr size_t WS_PAR = 7 * MiB;
constexpr int PAR_L = 21008, PR_NMG = 0, PR_NFG = 1024, PR_QNG = 2048, PR_KNG = 2112, PR_SUBG = 2176, PR_MHG = 2304, PR_BIG = 2560, PR_BFG = 2564, PR_CONVB = 2576, PR_CONVW = 4624, PR_GW = 12816;
constexpr size_t WS_SS = 7 * MiB + 512 * 1024;
constexpr size_t WS_B1 = 7 * MiB + 640 * 1024;
constexpr size_t WS_B1F = WS_B1 + 2 * 4096 * 8;
static_assert(WS_B1F + 4096 * 4 <= 8 * MiB, "B1F");
constexpr size_t WS_W = 8 * MiB;
constexpr size_t W_IN = 0, W_A = 18 * MiB, W_M = 20 * MiB, W_OUT = 22 * MiB, W_F1 = 24 * MiB, W_F2 = 32 * MiB;
constexpr size_t WS_XN = 48 * MiB;
constexpr size_t WS_MK = WS_XN;
constexpr size_t WS_Q = 80 * MiB, WS_K = 112 * MiB;
constexpr size_t WS_UB = WS_Q;
constexpr size_t WS_V8T = WS_K + 16 * MiB;
constexpr size_t WS_V = 144 * MiB;
constexpr size_t WS_MQ = WS_V;
constexpr size_t WS_FFU = WS_Q;
constexpr size_t WS_MQKR = 176 * MiB;
constexpr size_t WS_CST = WS_MQKR;
constexpr size_t WS_MV = 240 * MiB, WS_MO = 272 * MiB;
constexpr size_t WS_GAM = 304 * MiB;
constexpr size_t WS_YAM = 368 * MiB;
constexpr size_t WS_XB = WS_YAM;
constexpr size_t WS_W2 = 432 * MiB;
constexpr size_t WS_END = 472 * MiB;
static_assert(WS_SS + (size_t)S_ * 8 <= WS_B1 && WS_B1 + 2 * 4096 * 8 <= WS_W && WS_PAR + (size_t)DEPTH_ * PAR_L * 4 <= WS_SS && WS_NST + 512 * 1024 <= WS_PAR && WS_PAR + (size_t)DEPTH_ * PAR_L * 4 <= WS_W && WS_MODP + 16 * 24576 * 4 <= WS_MOD && WS_MOD + 24576 * 4 <= WS_TAB && WS_AA + 256 * 1024 <= WS_CHK && WS_MP + 4096 <= WS_NU, "small-region map");
static_assert(EP_Q == WS_Q && EP_K == WS_K && EP_V8T == WS_V8T && EP_V == WS_V && EP_MQKR == WS_MQKR && EP_MV == WS_MV && EP_MO == WS_MO && EP_GAM == WS_GAM, "projection epilogue offsets");

constexpr int LDS_BYTES = 147456;
constexpr int MISC_OFF = LDS_BYTES - 256;

#define GAS __attribute__((address_space(1)))
#define LAS __attribute__((address_space(3)))
typedef unsigned short bf16;
typedef unsigned v4u __attribute__((ext_vector_type(4)));
typedef unsigned v2u __attribute__((ext_vector_type(2)));
typedef float f32x4 __attribute__((ext_vector_type(4)));
typedef float f32x16 __attribute__((ext_vector_type(16)));
typedef short bf16x8 __attribute__((ext_vector_type(8)));
typedef short s16x4 __attribute__((ext_vector_type(4)));
typedef GAS unsigned gu32;
#define RLX_AGENT __ATOMIC_RELAXED, __HIP_MEMORY_SCOPE_AGENT
#define LDS_WAIT() asm volatile("s_waitcnt lgkmcnt(0)" ::: "memory")
#define VM_WAIT() asm volatile("s_waitcnt vmcnt(0)" ::: "memory")
__device__ __forceinline__ unsigned pk2(float lo, float hi) { return pg8::cvt_pk_bf16(lo, hi); }
__device__ __forceinline__ float bf2f(bf16 b) { return __uint_as_float((unsigned)b << 16); }
__device__ __forceinline__ bf16 f2bf(float f) { return (bf16)(pg8::cvt_pk_bf16(f, 0.f) & 0xffffu); }
__device__ __forceinline__ int crow(int r, int hi) { return (r & 3) + 8 * (r >> 2) + 4 * hi; }
__device__ __forceinline__ float half_sum(float v) {
    v += swz_xor<1>(v); v += swz_xor<2>(v); v += swz_xor<4>(v); v += swz_xor<8>(v); v += swz_xor<16>(v); return v;
}
__device__ __forceinline__ float half_max(float v) {
    v = fmaxf(v, swz_xor<1>(v)); v = fmaxf(v, swz_xor<2>(v)); v = fmaxf(v, swz_xor<4>(v)); v = fmaxf(v, swz_xor<8>(v)); v = fmaxf(v, swz_xor<16>(v)); return v;
}
__device__ __forceinline__ float swap_add(float v) { float lo, hi; halves(v, lo, hi); return lo + hi; }
__device__ __forceinline__ float wave_sum(float v) { return swap_add(half_sum(v)); }
__device__ __forceinline__ float wave_max(float v) { float lo, hi; halves(half_max(v), lo, hi); return fmaxf(lo, hi); }
typedef short v4i16_t __attribute__((ext_vector_type(4)));
__device__ __forceinline__ s16x4 vtr(const LAS unsigned char* p) { return __builtin_bit_cast(s16x4, __builtin_amdgcn_ds_read_tr16_b64_v4i16((LAS v4i16_t*)p)); }
__device__ __forceinline__ bf16x8 tr8(const LAS unsigned char* p, int second_off) {
    const s16x4 lo = vtr(p), hi = vtr(p + second_off);
    return (bf16x8){lo[0], lo[1], lo[2], lo[3], hi[0], hi[1], hi[2], hi[3]};
}
#define MFMA32(a, b, c) __builtin_amdgcn_mfma_f32_32x32x16_bf16(a, b, c, 0, 0, 0)

#define XB_TMO      128
#define XB_XCNT(j)  (256  + 64 * (j))
#define XB_XSUB(j)  (1280 + 64 * (j))
#define XB_XGEN(j)  (2304 + 64 * (j))
#define XB_TOP      3328
#define XB_TOPGEN   3392
#define XCD_BAR_WORDS 3456
#define XB_SPIN_CAP (1u << 18)

__device__ __forceinline__ unsigned xb_ld(unsigned* p)              { return __hip_atomic_load(p, __ATOMIC_RELAXED, __HIP_MEMORY_SCOPE_AGENT); }
__device__ __forceinline__ unsigned xb_add(unsigned* p, unsigned v) { return __hip_atomic_fetch_add(p, v, __ATOMIC_RELAXED, __HIP_MEMORY_SCOPE_AGENT); }
__device__ __forceinline__ unsigned xb_xcc_id() { return (unsigned)__builtin_amdgcn_s_getreg((3 << 11) | 20) & 0xFu; }
#define XB_SPIN(cond, bar) do { unsigned _sp = 0; while (cond) { __builtin_amdgcn_s_sleep(1); \
    if ((++_sp & 255u) == 0u) { if (xb_ld(&(bar)[XB_TMO])) break; if (_sp > XB_SPIN_CAP) { atomicAdd(&(bar)[XB_TMO], 1u); break; } } } } while (0)

struct XcdBarrier {
    unsigned* bar; unsigned x;
    volatile LAS unsigned* st;
};

__device__ __forceinline__ XcdBarrier xcd_barrier_post(unsigned* bar, volatile LAS unsigned* st) {
    XcdBarrier b; b.bar = bar; b.x = xb_xcc_id(); b.st = st;
    if (threadIdx.x == 0) (void)xb_add(&bar[XB_XCNT(b.x)], 1u);
    return b;
}
__device__ __forceinline__ void xcd_barrier_complete(unsigned* bar, unsigned x, unsigned& nloc, unsigned& nx) {
    const unsigned G = gridDim.x * gridDim.y * gridDim.z;
    unsigned sum, cnt, mine, sp = 0u;
    for (;;) {
        sum = 0u; cnt = 0u; mine = 0u;
#pragma unroll
        for (unsigned j = 0; j < 16; ++j) { const unsigned c = xb_ld(&bar[XB_XCNT(j)]); sum += c; cnt += (c > 0u) ? 1u : 0u; mine = (j == x) ? c : mine; }
        if (sum == G) break;
        __builtin_amdgcn_s_sleep(1);
        if ((++sp & 255u) == 0u) { if (xb_ld(&bar[XB_TMO])) break; if (sp > XB_SPIN_CAP) { atomicAdd(&bar[XB_TMO], 1u); break; } }
    }
    nloc = mine > 0u ? mine : 1u; nx = cnt > 0u ? cnt : 1u;
}

template <bool EXEC_ONLY = false>
__device__ __forceinline__ void xcd_barrier(const XcdBarrier& b, const bool is_thread0) {
    asm volatile("s_waitcnt vmcnt(0)" ::: "memory");
    __syncthreads();
    if (is_thread0) {
        unsigned* bar = b.bar;
        __builtin_amdgcn_s_waitcnt(0);
        unsigned nloc = b.st[0], nx = b.st[1];
        if (nloc == 0u) { xcd_barrier_complete(bar, b.x, nloc, nx); b.st[0] = nloc; b.st[1] = nx; }
        const unsigned old = xb_add(&bar[XB_XSUB(b.x)], 1u);
        const unsigned gen = old / nloc;
        if (old + 1u == (gen + 1u) * nloc) {
            if (!EXEC_ONLY) __builtin_amdgcn_fence(__ATOMIC_RELEASE, "agent");
            asm volatile("s_waitcnt vmcnt(0)" ::: "memory");
            const unsigned og = xb_add(&bar[XB_TOP], 1u);
            const unsigned tg = og / nx;
            if (og + 1u == (tg + 1u) * nx) xb_add(&bar[XB_TOPGEN], 1u);
            else XB_SPIN(xb_ld(&bar[XB_TOPGEN]) == tg, bar);
            if (!EXEC_ONLY) __builtin_amdgcn_fence(__ATOMIC_ACQUIRE, "agent");
            xb_add(&bar[XB_XGEN(b.x)], 1u);
            asm volatile("s_waitcnt vmcnt(0)" ::: "memory");
        } else {
            XB_SPIN(xb_ld(&bar[XB_XGEN(b.x)]) == gen, bar);
            if (!EXEC_ONLY) __builtin_amdgcn_fence(__ATOMIC_ACQUIRE, "agent");
            asm volatile("s_waitcnt vmcnt(0)" ::: "memory");
        }
    }
    __syncthreads();
}

struct Ctx { LAS unsigned char* lds; int tid, lane, wave, vcu, G; };

__device__ __forceinline__ void prologue_a(const Ctx& F, const float* c, const float* w_ada, float* modp) {
    const int gw = F.vcu * 8 + F.wave, NGW = F.G * 8;
    for (int it = gw; it < 96 * 16; it += NGW) {
        const int cg = it % 96, ks = it / 96; const int l = cg / 24, n0 = (cg % 24) * 256 + 4 * F.lane;
        const float* wp = w_ada + ((size_t)l * 1024 + ks * 64) * 6144 + n0;
        f32x4 a = {0.f, 0.f, 0.f, 0.f};
        const float cvl = c[ks * 64 + F.lane]; const float svl = cvl / (1.0f + __expf(-cvl));
#pragma unroll
        for (int kb = 0; kb < 2; ++kb) {
            f32x4 w[32];
#pragma unroll
            for (int k = 0; k < 32; ++k) w[k] = *(const f32x4*)(wp + (size_t)(32 * kb + k) * 6144);
#pragma unroll
            for (int k = 0; k < 32; ++k) a += __uint_as_float((unsigned)__builtin_amdgcn_readlane((int)__float_as_uint(svl), 32 * kb + k)) * w[k];
        }
        *(f32x4*)(modp + (size_t)ks * 24576 + cg * 256 + 4 * F.lane) = a;
    }
}
struct TrD { const float* W; bf16* WT; int ldw, K, k0, nsrc0, ndst0, kd, kind; float es; };
__device__ __forceinline__ void tr_load(const TrD& d, int lane, f32x4 (&r)[8]) {
#pragma unroll
    for (int i = 0; i < 8; ++i) { const int kk = 8 * i + (lane >> 3), n4 = 4 * (lane & 7); r[i] = *(const f32x4*)(d.W + (size_t)(d.k0 + kk) * d.ldw + d.nsrc0 + n4); }
}
__device__ __forceinline__ void tr_finish(const TrD& d, const f32x4 (&r)[8], LAS float* scr, int lane, const float* gs, const float* scf, const float* shf, u64* b1) {
#pragma unroll
    for (int i = 0; i < 8; ++i) { const int kk = 8 * i + (lane >> 3), n4 = 4 * (lane & 7); f32x4 wv_ = r[i];
        if (d.es > 0.f) { wv_.x = r8f(wv_.x, d.es); wv_.y = r8f(wv_.y, d.es); wv_.z = r8f(wv_.z, d.es); wv_.w = r8f(wv_.w, d.es); }
        LAS float* d_ = scr + kk * 33 + n4; d_[0] = wv_.x; d_[1] = wv_.y; d_[2] = wv_.z; d_[3] = wv_.w; }
    LDS_WAIT(); asm volatile("" ::: "memory");
    const int c = lane & 7; const int k0 = d.k0;
    if (d.kind == 1) {
#pragma unroll
        for (int j = 0; j < 4; ++j) { const int n = (lane >> 3) + 8 * j; const LAS float* s = scr + (8 * c) * 33 + n;
            int lo = __builtin_amdgcn_cvt_pk_fp8_f32(64.f * s[0 * 33], 64.f * s[1 * 33], 0, false); lo = __builtin_amdgcn_cvt_pk_fp8_f32(64.f * s[2 * 33], 64.f * s[3 * 33], lo, true);
            int hi = __builtin_amdgcn_cvt_pk_fp8_f32(64.f * s[4 * 33], 64.f * s[5 * 33], 0, false); hi = __builtin_amdgcn_cvt_pk_fp8_f32(64.f * s[6 * 33], 64.f * s[7 * 33], hi, true);
            v2u o; o.x = (unsigned)lo; o.y = (unsigned)hi;
            *(GAS v2u*)((unsigned char*)d.WT + (size_t)(d.ndst0 + n) * d.K * 2 + d.kd + k0 + 8 * c) = o; }
    } else if (d.kind == 2) {
        { const int n = lane & 31, kh = (lane >> 5) * 32; float p = 0.f;
#pragma unroll 8
          for (int kk = 0; kk < 32; ++kk) p += shf[k0 + kh + kk] * scr[(kh + kk) * 33 + n];
          atomicAdd(b1 + d.ndst0 + n, fx_enc(p, B1Q_)); }
        float sck[8];
#pragma unroll
        for (int e = 0; e < 8; ++e) sck[e] = gs[k0 + 8 * c + e] * (1.0f + scf[k0 + 8 * c + e]);
#pragma unroll
        for (int j = 0; j < 4; ++j) { const int n = (lane >> 3) + 8 * j; const LAS float* s = scr + (8 * c) * 33 + n;
            float sv_[8];
#pragma unroll
            for (int e = 0; e < 8; ++e) { sv_[e] = s[e * 33] * sck[e]; if (EMU8 & 2) sv_[e] = r8f(sv_[e], 64.f); }
            v4u o; o.x = pk2(sv_[0], sv_[1]); o.y = pk2(sv_[2], sv_[3]); o.z = pk2(sv_[4], sv_[5]); o.w = pk2(sv_[6], sv_[7]);
            *(GAS v4u*)(d.WT + (size_t)(d.ndst0 + n) * d.K + k0 + 8 * c) = o; }
    } else {
#pragma unroll
        for (int j = 0; j < 4; ++j) { const int n = (lane >> 3) + 8 * j; const LAS float* s = scr + (8 * c) * 33 + n;
            v4u o; o.x = pk2(s[0 * 33], s[1 * 33]); o.y = pk2(s[2 * 33], s[3 * 33]); o.z = pk2(s[4 * 33], s[5 * 33]); o.w = pk2(s[6 * 33], s[7 * 33]);
            *(GAS v4u*)(d.WT + (size_t)(d.ndst0 + n) * d.K + d.kd + k0 + 8 * c) = o; }
    }
    LDS_WAIT(); asm volatile("" ::: "memory");
}
__device__ __forceinline__ void prologue_b(const Ctx& F, const float* const* in, unsigned char* ws) {
    const int gt = F.vcu * 512 + F.tid;
    if (gt < 24576) { const float* mp = (const float*)(ws + WS_MODP); float s = in[3][gt];
#pragma unroll
        for (int k = 0; k < 16; ++k) s += mp[(size_t)k * 24576 + gt];
        ((float*)(ws + WS_MOD))[gt] = s; }
    if (gt >= 32768 && gt < 32768 + 1024) {
        const int i = gt - 32768, h = i >> 7, d = i & 127; const float* rel = in[13];
        int b; if (d < 16) b = d; else { const float nf = (float)d; int lg = 16 + (int)(logf(nf / 16.0f) / 2.0794415416798357f * 16.0f); b = lg < 31 ? lg : 31; }
        ((float*)(ws + WS_TAB))[i] = LOG2E_ * (rel[b * 8 + h] - rel[31 * 8 + h]); }
    if (gt >= 49152 && gt < 49152 + 4096) ((u64*)(ws + WS_B1))[gt - 49152] = zero64_opaque();
    if (gt >= 40960 && gt < 40960 + 4) {
        const int l = gt - 40960; const float* lq = in[11] + l * 256; float s01 = 0.f, s23 = 0.f;
        f32x4 a_[16], b_[16], c_[16], d_[16];
#pragma unroll
        for (int i = 0; i < 16; ++i) { a_[i] = *(const f32x4*)(lq + 4 * i); b_[i] = *(const f32x4*)(lq + 64 + 4 * i); c_[i] = *(const f32x4*)(lq + 128 + 4 * i); d_[i] = *(const f32x4*)(lq + 192 + 4 * i); }
#pragma unroll
        for (int i = 0; i < 16; ++i)
#pragma unroll
            for (int e = 0; e < 4; ++e) { s01 += a_[i][e] * b_[i][e]; s23 += c_[i][e] * d_[i][e]; }
        const float li = 0.8f - 0.6f * expf(-0.3f * (float)l);
        float* lt = (float*)(ws + WS_TAB + 4096) + l * 4; lt[0] = expf(s01) - expf(s23) + li; lt[1] = 1.0f - li; lt[2] = 0.f; lt[3] = 0.f; }
    { float* par = (float*)(ws + WS_PAR); const int NT = F.G * 512;
#define CP(off, src, n) for (int i = gt; i < DEPTH_ * (n); i += NT) { const int l_ = i / (n), j_ = i % (n); par[(size_t)l_ * PAR_L + (off) + j_] = (src)[i]; }
      CP(PR_NMG, in[4], 1024) CP(PR_NFG, in[5], 1024) CP(PR_QNG, in[9], 64) CP(PR_KNG, in[10], 64) CP(PR_SUBG, in[12], 128) CP(PR_MHG, in[16], 256)
      CP(PR_BIG, in[7], 4) CP(PR_BFG, in[8], 4) CP(PR_CONVB, in[15], 2048) CP(PR_CONVW, in[14], 8192)
#undef CP
      for (int i = gt; i < DEPTH_ * 8192; i += NT) { const int l_ = i >> 13, k_ = (i >> 3) & 1023, j_ = i & 7; par[(size_t)l_ * PAR_L + PR_GW + (i & 8191)] = in[6][((size_t)l_ * 1024 + k_) * NIN_SRC + GATE_COL + j_]; }
    }
}
__device__ __forceinline__ TrD wconv_item(int it, const float* const* in, unsigned char* wl, int l, int sel) {
    constexpr int I_IN = 16 * (NIN_ / 32), I_SQ = 16 * 32, I_F1 = 16 * 128;
    TrD d; d.W = nullptr; d.WT = nullptr; d.ldw = 0; d.K = 0; d.k0 = 0; d.nsrc0 = 0; d.ndst0 = 0; d.kd = 0; d.kind = -1; d.es = 0.f;
    int r = it;
    if (sel == 2 && (r < I_IN + 3 * I_SQ || r >= I_IN + 3 * I_SQ + I_F1)) return d;
    if (r < I_IN) { const int nb = r % (NIN_ / 32), kb = r / (NIN_ / 32); const int nd0 = nb * 32; int n = nd0;
        if (nd0 < 2048) { const int pn = nd0 >> 8, pc = nd0 & 255; n = pn * 256 + 64 * ((pc >> 5) & 3) + 32 * (pc >> 7); }
        d.W = in[6] + (size_t)l * 1024 * NIN_SRC; d.ldw = NIN_SRC; d.WT = (bf16*)(wl + W_IN); d.K = 1024; d.k0 = kb * 64; d.nsrc0 = n < GATE_COL ? n : n + 8; d.ndst0 = nd0;
        d.es = ((EMU8 & 1) || ((EMU8 & 8) && (nd0 < 2048 || nd0 >= 6144))) ? 64.f : 0.f; d.kind = (int)((PROJ8_TILES >> (nd0 >> 8)) & 1ull); return d; }
    r -= I_IN;
    if (r < 3 * I_SQ) { const int w = r / I_SQ, rr = r % I_SQ; const int nb = rr % 32, kb = rr / 32;
        d.W = in[17 + w] + (size_t)l * 1024 * 1024; d.ldw = 1024; d.k0 = kb * 64; d.nsrc0 = nb * 32; d.ndst0 = nb * 32; d.kind = 0;
        if (w < 2) { d.WT = (bf16*)(wl + W_A); d.K = 2048; d.kd = w * 1024; }
        else { d.WT = (bf16*)(wl + W_OUT); d.K = 1024; }
        return d; }
    r -= 3 * I_SQ;
    if (r < I_F1) { if (sel == 1) return d; const int nb = r % 128, kb = r / 128;
        d.W = in[20] + (size_t)l * 1024 * 4096; d.ldw = 4096; d.WT = (bf16*)(wl + W_F1); d.K = 1024; d.k0 = kb * 64; d.nsrc0 = nb * 32; d.ndst0 = nb * 32; d.kind = 2; return d; }
    r -= I_F1;
    { const int nb = r % 32, kb = r / 32;
      d.W = in[21] + (size_t)l * 4096 * 1024; d.ldw = 1024; d.WT = (bf16*)(wl + W_F2); d.K = 4096; d.k0 = kb * 64; d.nsrc0 = nb * 32; d.ndst0 = nb * 32; d.kind = 0; d.es = (EMU8 & 4) ? 128.f : 0.f; }
    return d;
}
__device__ __forceinline__ void wconv_layer(const Ctx& F, const float* const* in, unsigned char* wl, int l, int vcu0, const float* par_l, const float* mod_l, u64* b1, int sel = 0) {
    LAS float* scr = (LAS float*)(F.lds + F.wave * 16384);
    const int gw = (F.vcu - vcu0) * 8 + F.wave, NGW = (F.G - vcu0) * 8;
    constexpr int I_L = 16 * (NIN_ / 32) + 3 * 16 * 32 + 16 * 128 + 64 * 32;
    const float* gs = par_l ? par_l + PR_NFG : nullptr; const float* scf = mod_l ? mod_l + 4096 : nullptr; const float* shf = mod_l ? mod_l + 3072 : nullptr;
    int it = gw; TrD d; d.kind = -1; f32x4 r[8];
    if (it < I_L) { d = wconv_item(it, in, wl, l, sel); if (d.kind >= 0) tr_load(d, F.lane, r); }
    while (it < I_L) {
        const int itn = it + NGW; TrD dn; dn.kind = -1; f32x4 rn[8];
        if (itn < I_L) { dn = wconv_item(itn, in, wl, l, sel); if (dn.kind >= 0) tr_load(dn, F.lane, rn); }
        if (d.kind >= 0) tr_finish(d, r, scr, F.lane, gs, scf, shf, b1);
        d = dn; it = itn;
#pragma unroll
        for (int i = 0; i < 8; ++i) r[i] = rn[i];
    }
}
template <bool GATES>
__device__ __forceinline__ void norm_phase(const Ctx& F, const float* x, bf16* XN, const float* g, const float* sh, const float* sc,
                                           const float* win, const float* big, const float* bfg, float* IG, float* LF, u64* SS, u64* b1z, unsigned char* XN8 = nullptr) {
    const int gw = F.vcu * 8 + F.wave, NGW = F.G * 8; const int lane = F.lane;
    if (GATES) { const int gt = F.vcu * 512 + F.tid; if (gt < 4096) b1z[gt] = zero64_opaque(); }
    f32x4 gs[4], sv[4];
#pragma unroll
    for (int j = 0; j < 4; ++j) { const f32x4 gg = *(const f32x4*)(g + 4 * lane + 256 * j), s1 = *(const f32x4*)(sc + 4 * lane + 256 * j); gs[j] = gg * (1.0f + s1); sv[j] = *(const f32x4*)(sh + 4 * lane + 256 * j); }
    f32x4 wg[4][4][2];
    if (GATES) {
#pragma unroll
        for (int j = 0; j < 4; ++j)
#pragma unroll
            for (int i = 0; i < 4; ++i) { const float* wp = win + (size_t)(4 * lane + 256 * j + i) * 8; wg[j][i][0] = *(const f32x4*)wp; wg[j][i][1] = *(const f32x4*)(wp + 4); }
    }
    f32x4 vn[4];
    if (gw < S_) { const GAS f32x4* xr0 = (const GAS f32x4*)(x + (size_t)gw * 1024) + lane;
#pragma unroll
        for (int j = 0; j < 4; ++j) vn[j] = xr0[64 * j]; }
    for (int m = gw; m < S_; m += NGW) {
        f32x4 v[4]; float ss = 0.f;
#pragma unroll
        for (int j = 0; j < 4; ++j) v[j] = vn[j];
        if (m + NGW < S_) { const GAS f32x4* xr1 = (const GAS f32x4*)(x + (size_t)(m + NGW) * 1024) + lane;
#pragma unroll
            for (int j = 0; j < 4; ++j) vn[j] = xr1[64 * j]; }
#pragma unroll
        for (int j = 0; j < 4; ++j) ss += (v[j].x * v[j].x + v[j].y * v[j].y) + (v[j].z * v[j].z + v[j].w * v[j].w);
        const float r = 1.0f / sqrtf(wave_sum(ss) * (1.0f / 1024.0f) + EPS_);
        GAS v2u* o8 = (GAS v2u*)(XN + (size_t)m * 1024) + lane;
#pragma unroll
        for (int j = 0; j < 4; ++j) { v[j] = v[j] * r * gs[j] + sv[j]; f32x4 vq = v[j]; if (EMU8 & 1) { vq.x = r8f(vq.x, 1.f); vq.y = r8f(vq.y, 1.f); vq.z = r8f(vq.z, 1.f); vq.w = r8f(vq.w, 1.f); } v2u w; w.x = pk2(vq.x, vq.y); w.y = pk2(vq.z, vq.w); if (!(PROJ8 && GATES) || P8_HI > P8_LO) o8[64 * j] = w;
            if (PROJ8 && GATES) { int w8 = __builtin_amdgcn_cvt_pk_fp8_f32(v[j].x, v[j].y, 0, false); w8 = __builtin_amdgcn_cvt_pk_fp8_f32(v[j].z, v[j].w, w8, true);
                *(GAS int*)(XN8 + (size_t)m * 2048 + 4 * lane + 256 * j) = w8; } }
        if (GATES) {
            f32x4 d0 = {0.f, 0.f, 0.f, 0.f}, d1 = {0.f, 0.f, 0.f, 0.f};
#pragma unroll
            for (int j = 0; j < 4; ++j)
#pragma unroll
                for (int i = 0; i < 4; ++i) { d0 += v[j][i] * wg[j][i][0]; d1 += v[j][i] * wg[j][i][1]; }
#pragma unroll
            for (int q = 0; q < 4; ++q) { d0[q] = wave_sum(d0[q]); d1[q] = wave_sum(d1[q]); }
            if (lane == 0) SS[m] = zero64_opaque();
            if (lane < 4) {
                const float dq0 = lane == 0 ? d0[0] : (lane == 1 ? d0[1] : (lane == 2 ? d0[2] : d0[3])), dq1 = lane == 0 ? d1[0] : (lane == 1 ? d1[1] : (lane == 2 ? d1[2] : d1[3]));
                IG[(size_t)lane * S_ + m] = dq0 + big[lane]; const float z = dq1 + bfg[lane]; LF[(size_t)lane * S_ + m] = fminf(z, 0.f) - log1pf(__expf(-fabsf(z)));
            }
        }
    }
}

namespace att {
constexpr int QS_OFF = 73728;
constexpr int KSL8 = 8192, VSL = 8192, VRING = 4 * KSL8, BT_OFF = VRING + 4 * VSL, WS_OFF = BT_OFF + 2304;
__device__ __forceinline__ void glds(const void* g, LAS unsigned char* l) { __builtin_amdgcn_global_load_lds((const unsigned*)g, (LAS unsigned*)l, 16, 0, 0); }
#define SB0() __builtin_amdgcn_sched_barrier(0)
typedef float f32x2_t __attribute__((ext_vector_type(2))); typedef __bf16 bf16x2_t __attribute__((ext_vector_type(2)));
__device__ __forceinline__ unsigned cvtpk_s(float lo, float hi) { f32x2_t v = {lo, hi}; bf16x2_t b = __builtin_convertvector(v, bf16x2_t); return __builtin_bit_cast(unsigned, b); }
#define EXP2F(x) __builtin_amdgcn_exp2f(x)
#define PIN(x) asm volatile("" : "+v"(x))
template <bool NEAR>
__device__ __forceinline__ void ex4(const f32x16& P, int b, unsigned& w0, unsigned& w1, float& sacc, const LAS float* tb, int o) {
    float x0 = P[b], x1 = P[b + 1], x2 = P[b + 2], x3 = P[b + 3];
    if (NEAR) { x0 += tb[o]; x1 += tb[o + 1]; x2 += tb[o + 2]; x3 += tb[o + 3]; }
    x0 = EXP2F(x0); x1 = EXP2F(x1); x2 = EXP2F(x2); x3 = EXP2F(x3);
    w0 = cvtpk_s(x0, x1); w1 = cvtpk_s(x2, x3); sacc += (x0 + x1) + (x2 + x3);
    PIN(w0); PIN(w1); PIN(sacc);
}
#define DSR128(dst, addr, off) asm volatile("ds_read_b128 %0, %1 offset:" #off : "=v"(dst) : "v"(addr))
#define K8ADDR(kslot) ((kslot) + lofsK)
#define V8ADDR(vslot) ((vslot) + lofsV)
typedef int i32x8 __attribute__((ext_vector_type(8)));
typedef int i32x4 __attribute__((ext_vector_type(4)));
#define LD8(p, o0, o1) __builtin_shufflevector(*(const LAS i32x4*)((p) + (o0)), *(const LAS i32x4*)((p) + (o1)), 0, 1, 2, 3, 4, 5, 6, 7)
#define I8(a, c) ((i32x8){(int)(a).x, (int)(a).y, (int)(a).z, (int)(a).w, (int)(c).x, (int)(c).y, (int)(c).z, (int)(c).w})
#define P8(p, o) ((i32x8){p[o], p[o + 1], p[o + 2], p[o + 3], p[o + 4], p[o + 5], p[o + 6], p[o + 7]})
#define SC_PACK 0x7c7f
#define MFMA8QK(a, b) __builtin_amdgcn_mfma_scale_f32_32x32x64_f8f6f4(a, b, f32x16{}, 0, 0, 0, SC_PACK, 1, SC_PACK)
#define MFMA8PV(p, v, c) __builtin_amdgcn_mfma_scale_f32_32x32x64_f8f6f4(p, v, c, 1, 0, 0, SC_PACK, 0, SC_PACK)
template <bool NEAR>
__device__ __forceinline__ int ex4(const f32x16& P, int b, const LAS float* tb, int o) {
    float x0 = P[b], x1 = P[b + 1], x2 = P[b + 2], x3 = P[b + 3];
    if (NEAR) { x0 += tb[o]; x1 += tb[o + 1]; x2 += tb[o + 2]; x3 += tb[o + 3]; }
    x0 = EXP2F(x0); x1 = EXP2F(x1); x2 = EXP2F(x2); x3 = EXP2F(x3);
    int w; asm volatile("" : "=v"(w));
    w = __builtin_amdgcn_cvt_pk_bf8_f32(x0, x1, w, false);
    w = __builtin_amdgcn_cvt_pk_bf8_f32(x2, x3, w, true);
    return w;
}
#define MFMA8SUM(acc, p) asm volatile("v_mfma_scale_f32_16x16x128_f8f6f4 %0, %1, %2, %0, %3, %3 op_sel_hi:[0,0,0] blgp:1" : "+v"(acc) : "v"(aones), "v"(p), "v"(sc1))
template <bool NEAR>
__device__ __forceinline__ void tile_step(f32x16 (&o1)[4], f32x16 (&o2)[4], f32x4& s1, f32x4& s2, const LAS unsigned char* kslot, const LAS unsigned char* knext, const LAS unsigned char* vprev, const LAS unsigned char* qs,
                                          const LAS float* BT, int dist0, int lofsK, int lofsV, const i32x8 (&pp)[2], i32x8 (&pn)[2], i32x8& kf, i32x8& qf, const i32x8& aones, const int sc1, const i32x8& qg) {
    const LAS unsigned char* kb = K8ADDR(kslot); const LAS unsigned char* vp = V8ADDR(vprev); int dkn = (int)(knext - kslot); asm volatile("" : "+s"(dkn));
    const LAS float* tb = BT + (448 - dist0 + ((lofsK >> 9) & 4));
    i32x8 vf; f32x16 R0, R1;
    R0 = MFMA8QK(kf, qf);
    kf = LD8(kb, 512, 1536); vf = LD8(vp, 0, 2048);
    SB0();
    R1 = MFMA8QK(kf, qf);
    kf = LD8(kb, 4096, 5120);
    SB0();
    pn[0][0] = ex4<NEAR>(R0, 0, tb, 0);
    SB0();
    o1[0] = MFMA8PV(pp[0], vf, o1[0]);
    pn[0][1] = ex4<NEAR>(R0, 4, tb, 8);
    pn[0][2] = ex4<NEAR>(R0, 8, tb, 16);
    SB0();
    o2[0] = MFMA8PV(pp[1], vf, o2[0]);
    vf = LD8(vp, 512, 2560);
    pn[0][3] = ex4<NEAR>(R0, 12, tb, 24);
    SB0();
    R0 = MFMA8QK(kf, qg);
    kf = LD8(kb, 4608, 5632);
    pn[0][4] = ex4<NEAR>(R1, 0, tb, 32);
    SB0();
    o1[1] = MFMA8PV(pp[0], vf, o1[1]);
    MFMA8SUM(s1, pp[0]);
    pn[0][5] = ex4<NEAR>(R1, 4, tb, 40);
    pn[0][6] = ex4<NEAR>(R1, 8, tb, 48);
    SB0();
    o2[1] = MFMA8PV(pp[1], vf, o2[1]);
    vf = LD8(vp, 1024, 3072);
    pn[0][7] = ex4<NEAR>(R1, 12, tb, 56);
    SB0();
    R1 = MFMA8QK(kf, qg);
    { const LAS unsigned char* kn = kb + dkn; kf = LD8(kn, 0, 1024); }
    pn[1][0] = ex4<NEAR>(R0, 0, tb, 0);
    SB0();
    o1[2] = MFMA8PV(pp[0], vf, o1[2]);
    MFMA8SUM(s2, pp[1]);
    pn[1][1] = ex4<NEAR>(R0, 4, tb, 8);
    pn[1][2] = ex4<NEAR>(R0, 8, tb, 16);
    SB0();
    o2[2] = MFMA8PV(pp[1], vf, o2[2]);
    vf = LD8(vp, 1536, 3584);
    pn[1][3] = ex4<NEAR>(R0, 12, tb, 24);
    SB0();
    o1[3] = MFMA8PV(pp[0], vf, o1[3]);
    pn[1][4] = ex4<NEAR>(R1, 0, tb, 32);
    pn[1][5] = ex4<NEAR>(R1, 4, tb, 40);
    SB0();
    o2[3] = MFMA8PV(pp[1], vf, o2[3]);
    pn[1][6] = ex4<NEAR>(R1, 8, tb, 48);
    pn[1][7] = ex4<NEAR>(R1, 12, tb, 56);
    SB0();
}
__device__ __forceinline__ void pv_flush(f32x16 (&o1)[4], f32x16 (&o2)[4], const LAS unsigned char* vprev, int lofsK, int lofsV, const i32x8 (&pp)[2], f32x4& s1, f32x4& s2, const i32x8& aones, const int sc1) {
    const LAS unsigned char* vp = V8ADDR(vprev);
    i32x8 vf;
    vf = LD8(vp, 0, 2048);
    o1[0] = MFMA8PV(pp[0], vf, o1[0]);
    o2[0] = MFMA8PV(pp[1], vf, o2[0]);
    vf = LD8(vp, 512, 2560);
    o1[1] = MFMA8PV(pp[0], vf, o1[1]);
    o2[1] = MFMA8PV(pp[1], vf, o2[1]);
    vf = LD8(vp, 1024, 3072);
    o1[2] = MFMA8PV(pp[0], vf, o1[2]);
    o2[2] = MFMA8PV(pp[1], vf, o2[2]);
    vf = LD8(vp, 1536, 3584);
    o1[3] = MFMA8PV(pp[0], vf, o1[3]);
    o2[3] = MFMA8PV(pp[1], vf, o2[3]);
    MFMA8SUM(s1, pp[0]); MFMA8SUM(s2, pp[1]);
}
__device__ __forceinline__ void vtrans_phase(const Ctx& F, const bf16* Vb, unsigned char* V8T) {
    const int lane = F.lane; LAS unsigned char* blk = F.lds + F.wave * 8192;
    for (int it = F.vcu * 8 + F.wave; it < 8 * 256; it += F.G * 8) {
        const int h = it >> 8, T = it & 255;
#pragma unroll 4
        for (int i = 0; i < 16; ++i) { const int p = lane + 64 * i, key = p >> 4, ch = p & 15;
            const v4u w = *(const v4u*)(Vb + (size_t)(T * 64 + key) * 1024 + h * 128 + ch * 8);
            int lo = 0, hi4 = 0;
            lo = __builtin_amdgcn_cvt_pk_fp8_f32(pg8::bflo(w.x), pg8::bfhi(w.x), lo, false); lo = __builtin_amdgcn_cvt_pk_fp8_f32(pg8::bflo(w.y), pg8::bfhi(w.y), lo, true);
            hi4 = __builtin_amdgcn_cvt_pk_fp8_f32(pg8::bflo(w.z), pg8::bfhi(w.z), hi4, false); hi4 = __builtin_amdgcn_cvt_pk_fp8_f32(pg8::bflo(w.w), pg8::bfhi(w.w), hi4, true);
            const int pos = ((key >> 2) & 1) * 32 + ((key >> 5) & 1) * 16 + ((key >> 3) & 3) * 4 + (key & 3);
            LAS unsigned char* d = blk + (ch * 8) * 64 + pos;
            d[0 * 64] = (unsigned char)(lo); d[1 * 64] = (unsigned char)(lo >> 8); d[2 * 64] = (unsigned char)(lo >> 16); d[3 * 64] = (unsigned char)(lo >> 24);
            d[4 * 64] = (unsigned char)(hi4); d[5 * 64] = (unsigned char)(hi4 >> 8); d[6 * 64] = (unsigned char)(hi4 >> 16); d[7 * 64] = (unsigned char)(hi4 >> 24); }
        LDS_WAIT(); asm volatile("" ::: "memory");
        unsigned char* out = V8T + (size_t)it * 8192;
#pragma unroll
        for (int i = 0; i < 8; ++i) { const int p = lane + 64 * i; *(v4u*)(out + p * 16) = *(const LAS v4u*)(blk + p * 16); }
        LDS_WAIT(); asm volatile("" ::: "memory");
    }
}
__device__ __forceinline__ void epilogue(const Ctx& F, const f32x16 (&o1)[4], const f32x16 (&o2)[4], float l1, float l2, int h, int qw, bf16* Y, float lam, float oml, const float* subg) {
    const int lane = lane_id_opaque(), wid = F.wave, r32 = lane & 31, hi = lane >> 5;
    LAS float* wsf = (LAS float*)(F.lds + WS_OFF) + wid * 64;

    if (hi == 0) { wsf[r32] = 1.0f / l1; wsf[32 + r32] = lam / l2; }
    LDS_WAIT(); asm volatile("" ::: "memory");
    float gsub[4];
#pragma unroll
    for (int db = 0; db < 4; ++db) gsub[db] = subg[32 * db + r32] * oml;
#pragma unroll
    for (int r = 0; r < 16; ++r) {
        const int row = crow(r, hi); const float a = wsf[row], b = wsf[32 + row];
        float y[4]; float ss = 0.f;
#pragma unroll
        for (int db = 0; db < 4; ++db) { y[db] = o1[db][r] * a - o2[db][r] * b; ss += y[db] * y[db]; }
        ss = half_sum(ss);
        const float rs = __builtin_amdgcn_rsqf(ss * (1.0f / 128.0f) + EPS_);
        LAS unsigned char* sp = (r < 8 ? F.lds + wid * 4096 : F.lds + QS_OFF + wid * 4096) + (row & 15) * 256 + r32 * 2;
#pragma unroll
        for (int db = 0; db < 4; ++db) *(LAS bf16*)(sp + 64 * db) = f2bf(DBG_ATT_SCALE * y[db] * rs * gsub[db]);
    }
    LDS_WAIT(); asm volatile("" ::: "memory");
#pragma unroll
    for (int half = 0; half < 2; ++half) { const LAS unsigned char* stg = half ? F.lds + QS_OFF + wid * 4096 : F.lds + wid * 4096;
#pragma unroll
        for (int i = 0; i < 4; ++i) { const int p = lane + 64 * i, rowh = p >> 4, ch = p & 15;
            *(v4u*)(Y + (size_t)(qw + 16 * half + rowh) * 2048 + h * 128 + 8 * ch) = *(const LAS v4u*)(stg + rowh * 256 + ch * 16); } }
    asm volatile("s_waitcnt lgkmcnt(0)" ::: "memory"); __builtin_amdgcn_s_barrier(); asm volatile("" ::: "memory");
}
__device__ __forceinline__ void attn_unit(const Ctx& F, int h, int qb, const bf16* Qb, const unsigned char* K8, const unsigned char* V8T, bf16* Y, const float* bt2, float lam, float oml, const float* subg) {
    LAS unsigned char* lds = F.lds; const int lane = lane_id_opaque(), wid = F.wave, tid = wid * 64 + lane, r32 = lane & 31, hi = lane >> 5;
    const int q0 = qb * 256, NT = (q0 + 256) / 64, qw = q0 + 32 * wid;
    LAS float* BT = (LAS float*)(lds + BT_OFF);
    float btv = -INFINITY; { const int d = 448 - tid; if (d >= 0) btv = d < 128 ? bt2[d] : 0.f; }
    v2u qraw[2][4];
    { const unsigned char* Qrow = (const unsigned char*)Qb + (size_t)(qw + r32) * 1024 + h * 128;
#pragma unroll
      for (int cp = 0; cp < 2; ++cp)
#pragma unroll
          for (int d0 = 0; d0 < 4; ++d0) qraw[cp][d0] = *(const v2u*)(Qrow + cp * 64 + d0 * 16 + hi * 8); }
    const unsigned klo = (unsigned)(lane * 1024 + h * 128 + wid * 16);
    const unsigned vlo = (unsigned)((64 * (wid >> 2) + lane) * 64 + (wid & 3) * 16);
    LAS unsigned char* kd = lds + wid * 1024; LAS unsigned char* vd = lds + VRING + (wid & 3) * 2048 + (wid >> 2) * 1024;
#define ATT_DMA(t, b_) do { const char* kp_ = (const char*)K8 + (size_t)(t) * (64 * 1024); const char* vp_ = (const char*)V8T + ((size_t)h * 256 + (t)) * 8192; asm volatile("" : "+s"(kp_), "+s"(vp_)); \
        glds(kp_ + klo, kd + (b_) * KSL8); glds(vp_ + vlo, vd + (b_) * VSL); } while (0)
#define ATT_SYNC(n_) do { asm volatile("s_waitcnt vmcnt(" #n_ ") lgkmcnt(0)" ::: "memory"); __builtin_amdgcn_s_barrier(); asm volatile("" ::: "memory"); } while (0)
    f32x16 o1[4], o2[4];
#pragma unroll
    for (int i = 0; i < 4; ++i) { o1[i] = f32x16{}; o2[i] = f32x16{}; }
    f32x4 s1 = {0.f, 0.f, 0.f, 0.f}, s2 = {0.f, 0.f, 0.f, 0.f};
    int one8 = (lane == 0 || lane == 32 || lane == 17 || lane == 49) ? 0x38383838 : 0; asm volatile("" : "+v"(one8));
    const i32x8 aones = {one8, one8, one8, one8, one8, one8, one8, one8};
    const int sc1 = SC_PACK;
    asm volatile("s_waitcnt lgkmcnt(0)" ::: "memory"); __builtin_amdgcn_s_barrier(); asm volatile("" ::: "memory");
    { unsigned z_ = 0u; asm volatile("" : "+v"(z_)); *(LAS v4u*)(lds + VRING + 3 * VSL + tid * 16) = v4u{z_, z_, z_, z_}; }
    ATT_DMA(0, 0); ATT_DMA(1, 1);
    BT[tid] = btv; if (tid < 32) BT[512 + tid] = -INFINITY;
    i32x8 q8[2];
    {
#pragma unroll
      for (int cp = 0; cp < 2; ++cp)
#pragma unroll
          for (int d0 = 0; d0 < 4; ++d0) { q8[cp][2 * d0] = (int)qraw[cp][d0].x; q8[cp][2 * d0 + 1] = (int)qraw[cp][d0].y; } }
    LAS unsigned char* qs = lds + QS_OFF + wid * 4096 + lane * 16;
#pragma unroll
    for (int cp = 0; cp < 2; ++cp) { *(LAS i32x4*)(qs + cp * 2048) = __builtin_shufflevector(q8[cp], q8[cp], 0, 1, 2, 3); *(LAS i32x4*)(qs + cp * 2048 + 1024) = __builtin_shufflevector(q8[cp], q8[cp], 4, 5, 6, 7); }
    ATT_SYNC(0);
    int lofsK = hi * 2048 + r32 * 16, lofsV = hi * 4096 + r32 * 16; asm volatile("" : "+v"(lofsK), "+v"(lofsV));
    i32x8 pA[2], pB[2]; i32x8 kf, qf = q8[0];
    pA[0] = i32x8{}; pA[1] = i32x8{};
    { const LAS unsigned char* kb0 = K8ADDR(lds); kf = LD8(kb0, 0, 1024); }
#define KS_(t_) (lds + ((t_) & 3) * KSL8)
#define VS_(t_) (lds + VRING + ((t_) & 3) * VSL)
    const int tA = q0 >= 191 ? (q0 - 191) / 64 + 1 : 0;
    for (int t = 0; t < tA; t += 2) {
        ATT_DMA(t + 2, (t + 2) & 3);
        tile_step<false>(o1, o2, s1, s2, KS_(t), KS_(t + 1), VS_(t + 3), qs, BT, 0, lofsK, lofsV, pA, pB, kf, qf, aones, sc1, q8[1]);
        ATT_SYNC(0);
        ATT_DMA(t + 3, (t + 3) & 3);
        tile_step<false>(o1, o2, s1, s2, KS_(t + 1), KS_(t + 2), VS_(t), qs, BT, 0, lofsK, lofsV, pB, pA, kf, qf, aones, sc1, q8[1]);
        ATT_SYNC(0);
    }
    int qwr = qw + (lane_id_opaque() & 31); asm volatile("" : "+v"(qwr));
    for (int t = tA; t < NT; ++t) {
        if (t + 2 < NT) ATT_DMA(t + 2, (t + 2) & 3);
        if (64 * t <= qw + 31) {
            tile_step<true>(o1, o2, s1, s2, KS_(t), KS_(t + 1), VS_(t + 3), qs, BT, qwr - 64 * t, lofsK, lofsV, pA, pB, kf, qf, aones, sc1, q8[1]);
            pA[0] = pB[0]; pA[1] = pB[1];
        }
        ATT_SYNC(0);
    }
    { const int tl = min(NT - 1, (qw + 31) >> 6); pv_flush(o1, o2, VS_(tl), lofsK, lofsV, pA, s1, s2, aones, sc1); }
#undef KS_
#undef VS_
#undef ATT_DMA
#undef ATT_SYNC
    asm volatile("s_nop 15\n\ts_nop 15\n\ts_nop 15\n\ts_nop 15\n\ts_nop 15\n\ts_nop 15" : "+v"(s1), "+v"(s2));
    const int r32e = lane_id_opaque() & 31;
    float l10 = bperm(s1[0], r32e & 15), l11 = bperm(s1[1], r32e & 15), l20 = bperm(s2[0], r32e & 15), l21 = bperm(s2[1], r32e & 15);
    asm volatile("" : "+v"(l10), "+v"(l11), "+v"(l20), "+v"(l21));
    const float l1s = (r32e & 16) ? l11 : l10, l2s = (r32e & 16) ? l21 : l20;
    epilogue(F, o1, o2, l1s, l2s, h, qw, Y, lam, oml, subg);
}
}

namespace mls {
constexpr int L = 128, NC = S_ / L;
constexpr int ST1 = 520;
constexpr int VT_OFF = 0, KT_OFF = 128 * ST1, TB_OFF = 2 * 128 * ST1;
__device__ __forceinline__ void step1_unit(const Ctx& F, int l, int h, int c, const float* LF, const float* IG, float* BC, float* AA, float* BL, float* ML,
                                           const bf16* MQKR, const bf16* MV, bf16* MQ, bf16* MK, const float* conv_w, const float* conv_b, bf16* UB, float* NU) {
    LAS unsigned char* lds = F.lds; const int lane = lane_id_opaque(), wid = F.wave, tid = wid * 64 + lane, hi = lane >> 5;
    const int t0 = c * L; LAS float* wkt = (LAS float*)(lds + TB_OFF);
    const size_t gi = (size_t)h * S_ + t0 + 2 * lane;
    float lf0 = 0.f, lf1 = 0.f, ig0 = 0.f, ig1 = 0.f;
    if (wid == 0) { lf0 = LF[gi]; lf1 = LF[gi + 1]; ig0 = IG[gi]; ig1 = IG[gi + 1]; }
    v4u vt[8];
#pragma unroll
    for (int i = 0; i < 8; ++i) { const int idx = tid + 512 * i, row = idx >> 5, pc = idx & 31; vt[i] = *(const v4u*)(MV + (size_t)(t0 + row) * 1024 + h * 256 + pc * 8); }
    v4u rawq[11], rawk[11];
    { const int dg = tid & 31, rg = tid >> 5;
#pragma unroll
      for (int rr = 0; rr < 11; ++rr) { const int t = t0 + 8 * rg + rr - 3; rawq[rr] = (v4u){0u, 0u, 0u, 0u}; rawk[rr] = (v4u){0u, 0u, 0u, 0u};
          if (t >= 0) { rawq[rr] = *(const v4u*)(MQKR + (size_t)t * 2048 + h * 256 + 8 * dg); rawk[rr] = *(const v4u*)(MQKR + (size_t)t * 2048 + 1024 + h * 256 + 8 * dg); } } }
    if (wid == 0) {
        float s = lf0 + lf1;
#pragma unroll
        for (int o = 1; o < 64; o <<= 1) { const float y = bperm(s, lane - o); if (lane >= o) s += y; }
        const float bc1 = s, bc0 = s - lf1, blast = bperm(s, 63);
        const float a0 = ig0 - bc0, a1 = ig1 - bc1, g0 = blast + a0, g1 = blast + a1;
        const float mloc = wave_max(fmaxf(g0, g1));
        wkt[2 * lane] = __expf(g0 - mloc); wkt[2 * lane + 1] = __expf(g1 - mloc);
        BC[gi] = bc0; BC[gi + 1] = bc1; AA[gi] = a0; AA[gi + 1] = a1;
        if (lane == 0) { BL[h * NC + c] = blast; ML[h * NC + c] = mloc; }
    }
    f32x4 cwa[2][4][2], cba[2][2];
#define CONV_LD(W_) do { const int cb_ = (W_) * 1024 + h * 256 + 8 * (tid & 31); _Pragma("unroll") for (int j = 0; j < 4; ++j) { cwa[W_][j][0] = *(const f32x4*)(conv_w + (size_t)j * 2048 + cb_); cwa[W_][j][1] = *(const f32x4*)(conv_w + (size_t)j * 2048 + cb_ + 4); } \
        cba[W_][0] = *(const f32x4*)(conv_b + cb_); cba[W_][1] = *(const f32x4*)(conv_b + cb_ + 4); } while (0)
    CONV_LD(0);
#pragma unroll
    for (int i = 0; i < 8; ++i) { const int idx = tid + 512 * i, row = idx >> 5, pc = idx & 31;
        LAS v2u* d = (LAS v2u*)(lds + VT_OFF + row * ST1 + pc * 16); d[0] = (v2u){vt[i].x, vt[i].y}; d[1] = (v2u){vt[i].z, vt[i].w}; }
    CONV_LD(1);
#undef CONV_LD
    __syncthreads();
    { const int dg = tid & 31, rg = tid >> 5;
#pragma unroll
      for (int which = 0; which < 2; ++which) {
        float cw[4][8], cbias[8];
#pragma unroll
        for (int j = 0; j < 4; ++j) { const f32x4 w0 = cwa[which][j][0], w1 = cwa[which][j][1];
#pragma unroll
            for (int e = 0; e < 4; ++e) { cw[j][e] = w0[e]; cw[j][4 + e] = w1[e]; } }
        { const f32x4 b0 = cba[which][0], b1 = cba[which][1];
#pragma unroll
          for (int e = 0; e < 4; ++e) { cbias[e] = b0[e]; cbias[4 + e] = b1[e]; } }
        v4u raw[11];
#pragma unroll
        for (int rr = 0; rr < 11; ++rr) raw[rr] = which ? rawk[rr] : rawq[rr];
#pragma unroll
        for (int r = 0; r < 8; ++r) {
            float y[8];
#pragma unroll
            for (int e = 0; e < 8; ++e) y[e] = cbias[e];
#pragma unroll
            for (int j = 0; j < 4; ++j) { const v4u w = raw[r + j];
                y[0] += cw[j][0] * pg8::bflo(w.x); y[1] += cw[j][1] * pg8::bfhi(w.x); y[2] += cw[j][2] * pg8::bflo(w.y); y[3] += cw[j][3] * pg8::bfhi(w.y);
                y[4] += cw[j][4] * pg8::bflo(w.z); y[5] += cw[j][5] * pg8::bfhi(w.z); y[6] += cw[j][6] * pg8::bflo(w.w); y[7] += cw[j][7] * pg8::bfhi(w.w); }
            const float scl = which ? 0.0625f : 1.0f;
#pragma unroll
            for (int e = 0; e < 8; ++e) y[e] = y[e] * pg8::sigm(y[e]) * scl;
            const int row = 8 * rg + r;
            const v4u o = (v4u){pk2(y[0], y[1]), pk2(y[2], y[3]), pk2(y[4], y[5]), pk2(y[6], y[7])};
            *(v4u*)((which ? MK : MQ) + (size_t)(t0 + row) * 1024 + h * 256 + 8 * dg) = o;
            if (which) { const float wk = wkt[row];
                LAS v2u* d = (LAS v2u*)(lds + KT_OFF + row * ST1 + dg * 16);
                d[0] = (v2u){pk2(y[0] * wk, y[1] * wk), pk2(y[2] * wk, y[3] * wk)}; d[1] = (v2u){pk2(y[4] * wk, y[5] * wk), pk2(y[6] * wk, y[7] * wk)}; }
        }
      }
    }
    __syncthreads();
    if (tid < 256) { float s = 0.f; const LAS bf16* kp = (const LAS bf16*)(lds + KT_OFF) + tid;
#pragma unroll 8
        for (int r = 0; r < L; ++r) s += bf2f(kp[r * (ST1 / 2)]);
        NU[((size_t)h * NC + c) * 256 + tid] = s; }
    { const int eb = wid >> 1, dh = wid & 1;
      f32x16 acc[2][4];
#pragma unroll
      for (int mi = 0; mi < 2; ++mi)
#pragma unroll
          for (int ni = 0; ni < 4; ++ni) acc[mi][ni] = f32x16{};
      const int trow = 8 * hi + ((lane & 15) >> 2), tcol = 16 * ((lane >> 4) & 1) + 4 * (lane & 3);
      const LAS unsigned char* va = lds + VT_OFF + trow * ST1 + (64 * eb + tcol) * 2;
      const LAS unsigned char* ka = lds + KT_OFF + trow * ST1 + (128 * dh + tcol) * 2;
#pragma unroll 1
      for (int ks = 0; ks < 8; ++ks) {
          bf16x8 a[2], b[4];
#pragma unroll
          for (int mi = 0; mi < 2; ++mi) a[mi] = tr8(va + ks * 16 * ST1 + mi * 64, 4 * ST1);
#pragma unroll
          for (int ni = 0; ni < 4; ++ni) b[ni] = tr8(ka + ks * 16 * ST1 + ni * 64, 4 * ST1);
#pragma unroll
          for (int mi = 0; mi < 2; ++mi)
#pragma unroll
              for (int ni = 0; ni < 4; ++ni) acc[mi][ni] = MFMA32(a[mi], b[ni], acc[mi][ni]);
      }
      __syncthreads();
      LAS unsigned char* stg = lds + wid * 17408;
#pragma unroll
      for (int mi = 0; mi < 2; ++mi)
#pragma unroll
          for (int ni = 0; ni < 4; ++ni)
#pragma unroll
              for (int r = 0; r < 16; ++r) *(LAS bf16*)(stg + (32 * mi + crow(r, hi)) * 272 + (32 * ni + (lane & 31)) * 2) = f2bf(acc[mi][ni][r]);
      LDS_WAIT(); asm volatile("" ::: "memory");
      bf16* up = UB + ((size_t)h * NC + c) * 65536 + (size_t)(64 * eb) * 256 + 128 * dh;
#pragma unroll
      for (int i = 0; i < 16; ++i) { const int p = lane + 64 * i, row = p >> 4, ch = p & 15; *(v4u*)(up + (size_t)row * 256 + 8 * ch) = *(const LAS v4u*)(stg + row * 272 + ch * 16); }
    }
    __syncthreads();
}
__device__ __forceinline__ double bperm64(double v, int src_lane) { const unsigned long long b = __builtin_bit_cast(unsigned long long, v);
    const unsigned lo = (unsigned)__builtin_amdgcn_ds_bpermute(src_lane << 2, (int)(unsigned)b), hi = (unsigned)__builtin_amdgcn_ds_bpermute(src_lane << 2, (int)(unsigned)(b >> 32));
    return __builtin_bit_cast(double, ((unsigned long long)hi << 32) | lo); }
struct GateTab { float fa0, fb0, mp0, fa1, fb1, mp1; };
__device__ __forceinline__ GateTab gate_tables(const float* BL, const float* ML, int h, int lane) {
    const float blf0 = BL[h * NC + 2 * lane], blf1 = BL[h * NC + 2 * lane + 1], mlf0 = ML[h * NC + 2 * lane], mlf1 = ML[h * NC + 2 * lane + 1];
    const double bl0 = blf0, bl1 = blf1, ml0 = mlf0, ml1 = mlf1;
    double ps = bl0 + bl1;
#pragma unroll
    for (int o = 1; o < 64; o <<= 1) { const double y = bperm64(ps, lane - o); if (lane >= o) ps += y; }
    const double S1 = ps, S0 = ps - bl1, t0 = ml0 - S0, t1 = ml1 - S1;
    double pmx = fmax(t0, t1);
#pragma unroll
    for (int o = 1; o < 64; o <<= 1) { const double y = bperm64(pmx, lane - o); if (lane >= o) pmx = fmax(pmx, y); }
    double prev = bperm64(pmx, lane - 1); if (lane == 0) prev = -1.0e300;
    const double PM0 = fmax(prev, t0), m0 = S0 + fmax(0.0, PM0), m1 = S1 + fmax(0.0, pmx);
    double mprev0 = bperm64(m1, lane - 1); if (lane == 0) mprev0 = 0.0;
    GateTab g; g.fa0 = __expf((float)(bl0 + mprev0 - m0)); g.fb0 = __expf((float)(ml0 - m0)); g.mp0 = (float)mprev0;
    g.fa1 = __expf((float)(bl1 + m0 - m1)); g.fb1 = __expf((float)(ml1 - m1)); g.mp1 = (float)m0;
    return g;
}
__device__ __forceinline__ float rdl(float v, int l) { return __uint_as_float((unsigned)__builtin_amdgcn_readlane((int)__float_as_uint(v), l)); }
__device__ __forceinline__ void scan_phase(const Ctx& F, const bf16* UB, bf16* CST, const float* BL, const float* ML, float* MP, const float* NU, float* NST) {
    const int gt = F.vcu * 512 + F.tid, lane = F.tid & 63;
    if (gt < 65536) {
        const int h = gt >> 14, e = (gt >> 6) & 255, d0 = 4 * (gt & 63);
        const size_t base = (size_t)h * NC * 65536 + (size_t)e * 256 + d0;
        v2u ua[16], ub[16];
#pragma unroll
        for (int i = 0; i < 16; ++i) ua[i] = *(const v2u*)(UB + base + (size_t)i * 65536);
        const GateTab g = gate_tables(BL, ML, h, lane);
        if ((gt & 16383) < 64) { MP[h * NC + 2 * lane] = g.mp0; MP[h * NC + 2 * lane + 1] = g.mp1; }
        float C0 = 0.f, C1 = 0.f, C2 = 0.f, C3 = 0.f;
#define SCAN_STEPS(U, CB) _Pragma("unroll") for (int i = 0; i < 16; ++i) { \
                *(v2u*)(CST + base + (size_t)((CB) + i) * 65536) = (v2u){pk2(C0, C1), pk2(C2, C3)}; \
                const float fa = rdl((i & 1) ? g.fa1 : g.fa0, ((CB) >> 1) + (i >> 1)), fb = rdl((i & 1) ? g.fb1 : g.fb0, ((CB) >> 1) + (i >> 1)); \
                C0 = fa * C0 + fb * pg8::bflo(U[i].x); C1 = fa * C1 + fb * pg8::bfhi(U[i].x); C2 = fa * C2 + fb * pg8::bflo(U[i].y); C3 = fa * C3 + fb * pg8::bfhi(U[i].y); }
#pragma unroll 1
        for (int c8 = 0; c8 < NC; c8 += 32) {
#pragma unroll
            for (int i = 0; i < 16; ++i) ub[i] = *(const v2u*)(UB + base + (size_t)(c8 + 16 + i) * 65536);
            SCAN_STEPS(ua, c8)
            if (c8 + 32 < NC) {
#pragma unroll
                for (int i = 0; i < 16; ++i) ua[i] = *(const v2u*)(UB + base + (size_t)(c8 + 32 + i) * 65536); }
            SCAN_STEPS(ub, c8 + 16)
        }
#undef SCAN_STEPS
    } else if (gt < 65536 + 256) {
        const int idx = gt - 65536, h = idx >> 6, d0 = 4 * (idx & 63);
        f32x4 ua[16], ub[16];
#pragma unroll
        for (int i = 0; i < 16; ++i) ua[i] = *(const f32x4*)(NU + ((size_t)h * NC + i) * 256 + d0);
        const GateTab g = gate_tables(BL, ML, h, lane);
        f32x4 n = {0.f, 0.f, 0.f, 0.f};
#define NSCAN_STEPS(U, CB) _Pragma("unroll") for (int i = 0; i < 16; ++i) { \
                *(f32x4*)(NST + ((size_t)h * NC + (CB) + i) * 256 + d0) = n; \
                const float fa = rdl((i & 1) ? g.fa1 : g.fa0, ((CB) >> 1) + (i >> 1)), fb = rdl((i & 1) ? g.fb1 : g.fb0, ((CB) >> 1) + (i >> 1)); \
                n = fa * n + fb * U[i]; }
#pragma unroll 1
        for (int c8 = 0; c8 < NC; c8 += 32) {
#pragma unroll
            for (int i = 0; i < 16; ++i) ub[i] = *(const f32x4*)(NU + ((size_t)h * NC + c8 + 16 + i) * 256 + d0);
            NSCAN_STEPS(ua, c8)
            if (c8 + 32 < NC) {
#pragma unroll
                for (int i = 0; i < 16; ++i) ua[i] = *(const f32x4*)(NU + ((size_t)h * NC + c8 + 32 + i) * 256 + d0); }
            NSCAN_STEPS(ub, c8 + 16)
        }
#undef NSCAN_STEPS
    }
}
constexpr int ST3 = 528;
constexpr int K3_OFF = 0, V3_OFF = 128 * ST3, T3_OFF = 2 * 128 * ST3;
__device__ __forceinline__ void step3_unit(const Ctx& F, int h, int c, const bf16* MQ, const bf16* MK, const bf16* MV, const bf16* CST, const float* NST, const float* MP, const float* AA, const float* BC,
                                           const bf16* MO, const float* mhg, bf16* Y) {
    LAS unsigned char* lds = F.lds; const int lane = lane_id_opaque(), wid = F.wave, tid = wid * 64 + lane, r32 = lane & 31, hi = lane >> 5;
    const int t0 = c * L;
    LAS float* aat = (LAS float*)(lds + T3_OFF); LAS float* att_ = aat + 128; LAS float* ait = aat + 256; LAS float* nvt = aat + 384; LAS float* pst = aat + 640; LAS float* rvt = aat + 896;
    const size_t gi = (size_t)h * S_ + t0 + 2 * lane; float a0 = 0.f, a1 = 0.f, mp = 0.f; f32x4 nv4 = {0.f, 0.f, 0.f, 0.f};
    if (wid == 0) { a0 = AA[gi]; a1 = AA[gi + 1]; mp = MP[h * NC + c]; }
    if (wid == 1) nv4 = *(const f32x4*)(NST + ((size_t)h * NC + c) * 256 + 4 * lane);
    const int rg = wid >> 1, eh = wid & 1; const int tr = 32 * rg + r32;
    const float bcv = BC[(size_t)h * S_ + t0 + tr];
    float gm[4];
#pragma unroll
    for (int db = 0; db < 4; ++db) gm[db] = mhg[128 * eh + 32 * db + r32];
    bf16x8 qf[16];
    { const bf16* qp = MQ + (size_t)(t0 + tr) * 1024 + h * 256 + 8 * hi;
#pragma unroll
      for (int k0 = 0; k0 < 16; ++k0) qf[k0] = *(const bf16x8*)(qp + 16 * k0); }
    { const bf16* cbase = CST + ((size_t)h * NC + c) * 65536;
#pragma unroll
      for (int i = 0; i < 16; ++i) { const int idx = tid + 512 * i, row = idx >> 5, pc = idx & 31;
          *(LAS v4u*)(lds + row * ST3 + pc * 16) = *(const v4u*)(cbase + (size_t)row * 256 + pc * 8); } }
    if (wid == 0) {
        float s = fmaxf(a0, a1);
#pragma unroll
        for (int o = 1; o < 64; o <<= 1) { const float y = bperm(s, lane - o); if (lane >= o) s = fmaxf(s, y); }
        float prev = bperm(s, lane - 1); if (lane == 0) prev = -INFINITY;
        const float A0 = fmaxf(mp, fmaxf(prev, a0)), A1 = fmaxf(mp, s);
        aat[2 * lane] = a0; aat[2 * lane + 1] = a1; att_[2 * lane] = A0; att_[2 * lane + 1] = A1; ait[2 * lane] = __expf(mp - A0); ait[2 * lane + 1] = __expf(mp - A1);
    }
    if (wid == 1) *(LAS f32x4*)(nvt + 4 * lane) = nv4;
    __syncthreads();
    v4u kreg[8], vreg[8];
#pragma unroll
    for (int i = 0; i < 8; ++i) { const int idx = tid + 512 * i, row = idx >> 5, pc = idx & 31;
        kreg[i] = *(const v4u*)(MK + (size_t)(t0 + row) * 1024 + h * 256 + pc * 8); vreg[i] = *(const v4u*)(MV + (size_t)(t0 + row) * 1024 + h * 256 + pc * 8); }
    f32x16 acc[4];
#pragma unroll
    for (int db = 0; db < 4; ++db) acc[db] = f32x16{};
    { const LAS unsigned char* cb = lds + (128 * eh + r32) * ST3 + 16 * hi;
#pragma unroll
      for (int k0 = 0; k0 < 16; ++k0) {
          bf16x8 cf[4];
#pragma unroll
          for (int db = 0; db < 4; ++db) cf[db] = *(const LAS bf16x8*)(cb + (32 * db) * ST3 + 32 * k0);
#pragma unroll
          for (int db = 0; db < 4; ++db) acc[db] = MFMA32(qf[k0], cf[db], acc[db]);
      }
    }
#pragma unroll
    for (int r = 0; r < 16; ++r) { const float a = ait[32 * rg + crow(r, hi)];
#pragma unroll
        for (int db = 0; db < 4; ++db) acc[db][r] *= a; }
    __syncthreads();
#pragma unroll
    for (int i = 0; i < 8; ++i) { const int idx = tid + 512 * i, row = idx >> 5, pc = idx & 31;
        *(LAS v4u*)(lds + K3_OFF + row * ST3 + pc * 16) = kreg[i]; *(LAS v4u*)(lds + V3_OFF + row * ST3 + pc * 16) = vreg[i]; }
    __syncthreads();
    float nq = 0.f;
#pragma unroll
    for (int k0 = 0; k0 < 16; ++k0) { const v4u w = __builtin_bit_cast(v4u, qf[k0]); const LAS float* np = nvt + 16 * k0 + 8 * hi;
        nq += pg8::bflo(w.x) * np[0] + pg8::bfhi(w.x) * np[1] + pg8::bflo(w.y) * np[2] + pg8::bfhi(w.y) * np[3] + pg8::bflo(w.z) * np[4] + pg8::bfhi(w.z) * np[5] + pg8::bflo(w.w) * np[6] + pg8::bfhi(w.w) * np[7]; }
    nq = swap_add(nq);
    const float At = att_[tr];
    float dsum = 0.f;
    const LAS unsigned char* vb = lds + V3_OFF + (4 * hi + ((lane & 15) >> 2)) * ST3 + (128 * eh + 16 * ((lane >> 4) & 1) + 4 * (lane & 3)) * 2;
    for (int kt = 0; kt <= (rg >> 1); ++kt) {
        f32x16 p0 = f32x16{}, p1 = f32x16{};
        const LAS unsigned char* kb = lds + K3_OFF + (64 * kt + r32) * ST3 + 16 * hi;
#pragma unroll
        for (int k0 = 0; k0 < 16; ++k0) { const bf16x8 ka = *(const LAS bf16x8*)(kb + 32 * k0), kc = *(const LAS bf16x8*)(kb + 32 * ST3 + 32 * k0);
            p0 = MFMA32(ka, qf[k0], p0); p1 = MFMA32(kc, qf[k0], p1); }
#pragma unroll
        for (int r = 0; r < 16; ++r) { const int s0 = 64 * kt + crow(r, hi), s1 = s0 + 32;
            const float w0 = s0 <= tr ? __builtin_amdgcn_exp2f((aat[s0] - At) * LOG2E_) : 0.f, w1 = s1 <= tr ? __builtin_amdgcn_exp2f((aat[s1] - At) * LOG2E_) : 0.f;
            p0[r] *= w0; p1[r] *= w1; dsum += p0[r] + p1[r]; }
        v4u pw[4];
        pw[0] = (v4u){pk2(p0[0], p0[1]), pk2(p0[2], p0[3]), pk2(p0[4], p0[5]), pk2(p0[6], p0[7])};
        pw[1] = (v4u){pk2(p0[8], p0[9]), pk2(p0[10], p0[11]), pk2(p0[12], p0[13]), pk2(p0[14], p0[15])};
        pw[2] = (v4u){pk2(p1[0], p1[1]), pk2(p1[2], p1[3]), pk2(p1[4], p1[5]), pk2(p1[6], p1[7])};
        pw[3] = (v4u){pk2(p1[8], p1[9]), pk2(p1[10], p1[11]), pk2(p1[12], p1[13]), pk2(p1[14], p1[15])};
#pragma unroll
        for (int ks = 0; ks < 4; ++ks)
#pragma unroll
            for (int db = 0; db < 4; ++db) { const bf16x8 vf = tr8(vb + (64 * kt + 16 * ks) * ST3 + db * 64, 8 * ST3); acc[db] = MFMA32(__builtin_bit_cast(bf16x8, pw[ks]), vf, acc[db]); }
    }
    v4u mo[8];
#pragma unroll
    for (int i = 0; i < 8; ++i) { const int p = lane + 64 * i; mo[i] = *(const v4u*)(MO + (size_t)(t0 + 32 * rg + (p >> 4)) * 1024 + h * 256 + 128 * eh + 8 * (p & 15)); }
    dsum = swap_add(dsum);
    { const float den = dsum + ait[tr] * nq; const float mt = bcv + At;
      if (hi == 0) rvt[wid * 32 + r32] = 1.0f / fmaxf(fabsf(den), __expf(-mt)); }
    LDS_WAIT(); asm volatile("" ::: "memory");
    float rv[16];
#pragma unroll
    for (int r = 0; r < 16; ++r) { rv[r] = rvt[wid * 32 + crow(r, hi)]; float ss = 0.f;
#pragma unroll
        for (int db = 0; db < 4; ++db) { acc[db][r] *= rv[r]; ss += acc[db][r] * acc[db][r]; }
        ss = half_sum(ss); if (r32 == 0) pst[wid * 32 + crow(r, hi)] = ss; }
    __syncthreads();
    LAS unsigned char* stg = lds + K3_OFF + wid * 8704;
#pragma unroll
    for (int r = 0; r < 16; ++r) { const int row = crow(r, hi); const float tot = pst[wid * 32 + row] + pst[(wid ^ 1) * 32 + row];
        const float rs = __builtin_amdgcn_rsqf(tot * (1.0f / 256.0f) + EPS_);
#pragma unroll
        for (int db = 0; db < 4; ++db) *(LAS bf16*)(stg + row * 272 + (32 * db + r32) * 2) = f2bf(acc[db][r] * rs * gm[db]); }
    LDS_WAIT(); asm volatile("" ::: "memory");
#pragma unroll
    for (int i = 0; i < 8; ++i) { const int p = lane + 64 * i, row = p >> 4, ch = p & 15;
        const v4u hv = *(const LAS v4u*)(stg + row * 272 + ch * 16); const v4u mv = mo[i]; v4u o;
        o.x = pk2(DBG_MLS_SCALE * pg8::bflo(hv.x) * pg8::bflo(mv.x), DBG_MLS_SCALE * pg8::bfhi(hv.x) * pg8::bfhi(mv.x)); o.y = pk2(DBG_MLS_SCALE * pg8::bflo(hv.y) * pg8::bflo(mv.y), DBG_MLS_SCALE * pg8::bfhi(hv.y) * pg8::bfhi(mv.y));
        o.z = pk2(DBG_MLS_SCALE * pg8::bflo(hv.z) * pg8::bflo(mv.z), DBG_MLS_SCALE * pg8::bfhi(hv.z) * pg8::bfhi(mv.z)); o.w = pk2(DBG_MLS_SCALE * pg8::bflo(hv.w) * pg8::bflo(mv.w), DBG_MLS_SCALE * pg8::bfhi(hv.w) * pg8::bfhi(mv.w));
        *(v4u*)(Y + (size_t)(t0 + 32 * rg + row) * 2048 + 1024 + h * 256 + 128 * eh + 8 * ch) = o; }
    __syncthreads();
}
}

#ifndef REPMASK
#define REPMASK 0
#endif
#ifndef PHMASK
#define PHMASK 0x3fff
#endif
constexpr int NPH_LAYER = 12, NPHASES = 2 + DEPTH_ * NPH_LAYER;
struct Args { const float* in[22]; float* out; unsigned char* ws; int ph_lo, ph_hi; };
__global__ void __launch_bounds__(512, 2) fwd(Args args) {
    extern __shared__ __attribute__((aligned(16))) unsigned char lds_raw[];
    Ctx F;
    F.lds = (LAS unsigned char*)lds_raw;
    F.tid = threadIdx.x; F.lane = F.tid & 63; F.wave = __builtin_amdgcn_readfirstlane(F.tid >> 6);
    F.G = gridDim.x; { const int bx = blockIdx.x; F.vcu = (F.G % 8 == 0) ? (bx % 8) * (F.G / 8) + bx / 8 : bx; }
    volatile LAS unsigned* MISC = (volatile LAS unsigned*)(F.lds + MISC_OFF);
    if (F.tid < 64) MISC[F.tid] = 0u;
    __syncthreads();
    unsigned char* ws = args.ws;
    const int lo = args.ph_lo, hi = args.ph_hi;
    const bool use_bar = (hi - lo) > 1;
    XcdBarrier bar; bar.bar = (unsigned*)(ws + WS_CTL) + 1024; bar.x = 0; bar.st = nullptr;
    if (use_bar) bar = xcd_barrier_post((unsigned*)(ws + WS_CTL) + 1024, MISC + 8);
#define IN(k) (lo <= (k) && (k) < hi)
#define FRESH(Fx) Ctx Fx = F; Fx.lane = lane_id_opaque(); Fx.tid = Fx.wave * 64 + Fx.lane; asm volatile("" : "+s"(Fx.vcu), "+s"(Fx.G)); unsigned char* wsl = ws; asm volatile("" : "+s"(wsl)); int lq = l; asm volatile("" : "+s"(lq))
#define SEAM_(k, X) do { if (IN((k) + 1)) { XcdBarrier b_ = bar; asm volatile("" : "+s"(b_.bar)); xcd_barrier<X>(b_, F.wave == 0 && lane_id_opaque() == 0); } } while (0)
#define SEAM(k) SEAM_(k, false)
    const float* const* in = args.in;
    float* xout = args.out;
#define P_BF(off) ((bf16*)(wsl + (off)))
#define P_F32(off) ((float*)(wsl + (off)))
#define L_MOD ((const float*)(wsl + WS_MOD) + lq * 6144)
#define L_PAR ((const float*)(wsl + WS_PAR) + (size_t)lq * PAR_L)
#define L_WL (wsl + ((lq & 1) ? WS_W2 : WS_W))
#define L_XSRC ((lq == 0) ? in[0] : xout)
#define L_B1(ll) ((u64*)(wsl + WS_B1) + ((ll) & 1) * 4096)
    if (IN(0) && (PHMASK >> 12 & 1)) { prologue_a(F, in[1], in[2], (float*)(ws + WS_MODP)); wconv_layer(F, in, ws + WS_W, 0, 0, nullptr, nullptr, nullptr, 1);     SEAM(0); }
    if (IN(1) && (PHMASK >> 13 & 1)) { prologue_b(F, in, ws); __syncthreads(); SEAM(1); }

    for (int l = 0; l < DEPTH_; ++l) {
        const int pb = 2 + NPH_LAYER * l;
        if (IN(pb + 0) && (PHMASK >> 0 & 1)) { FRESH(Fp);
          _Pragma("unroll 1") for (int rep_ = 0; rep_ < 1 + ((REPMASK >> 0) & 1); ++rep_) {
            if (lq == 0) wconv_layer(Fp, in, L_WL, 0, 0, L_PAR, L_MOD, L_B1(0), 2);
            norm_phase<true>(Fp, L_XSRC, P_BF(WS_XN), L_PAR + PR_NMG, L_MOD + 0, L_MOD + 1024, L_PAR + PR_GW, L_PAR + PR_BIG, L_PAR + PR_BFG, P_F32(WS_IG), P_F32(WS_LF), (u64*)(wsl + WS_SS), L_B1(lq + 1), wsl + WS_YAM);
            SEAM(pb + 0);
          }
        }
        if (IN(pb + 1) && (PHMASK >> 1 & 1)) { FRESH(Fp);
          _Pragma("unroll 1") for (int rep_ = 0; rep_ < 1 + ((REPMASK >> 1) & 1); ++rep_) {
            pg8::EpiProj E{wsl, L_PAR + PR_QNG, L_PAR + PR_KNG};
#if PROJ8
            {
                constexpr int NT8 = 36 - (P8_HI - P8_LO); pg8::Gemm g{P_BF(WS_YAM), (const bf16*)(L_WL + W_IN), S_, NT8 * 256, 512, 1024, 1024}; pg8::SubsetOrder<P8_LO, P8_HI - P8_LO> So; So.init(S_, NT8 * 256, Fp.G, (int)blockIdx.x);
                pg8::gemm_phase<pg8::EpiProj, pg8::SubsetOrder<P8_LO, P8_HI - P8_LO>, true, true, true>(Fp.lds, g, So, E, Fp.wave); }
#if P8_HI > P8_LO
            {
                constexpr int NTB = P8_HI - P8_LO; pg8::Gemm g{P_BF(WS_XN), (const bf16*)(L_WL + W_IN), S_, NTB * 256, 1024, 1024, 1024}; pg8::SubsetOrder<0, P8_LO> So; So.init(S_, NTB * 256, Fp.G, (int)blockIdx.x);
                pg8::gemm_phase<pg8::EpiProj, pg8::SubsetOrder<0, P8_LO>, true, true>(Fp.lds, g, So, E, Fp.wave); }
#endif
#else
            { pg8::Gemm g{P_BF(WS_XN), (const bf16*)(L_WL + W_IN), S_, NIN_, 1024, 1024, 1024}; pg8::StaticOrder So; So.init(S_, NIN_, Fp.G, (int)blockIdx.x);
              pg8::gemm_phase<pg8::EpiProj, pg8::StaticOrder, true, true>(Fp.lds, g, So, E, Fp.wave); }
#endif
            SEAM(pb + 1);
          }
        }
        if (IN(pb + 2) && (PHMASK >> 2 & 1)) { FRESH(Fp);
          _Pragma("unroll 1") for (int rep_ = 0; rep_ < 1 + ((REPMASK >> 2) & 1); ++rep_) {
            const float* lt = (const float*)(wsl + WS_TAB + 4096) + lq * 4; const float lam = __uint_as_float(__builtin_amdgcn_readfirstlane(__float_as_uint(lt[0]))), oml = __uint_as_float(__builtin_amdgcn_readfirstlane(__float_as_uint(lt[1])));
            if (Fp.wave >= 4) __builtin_amdgcn_s_setprio(1);
            for (int p = Fp.vcu; p < 256; p += Fp.G) {
                const int h = p >> 5, s = p & 31;
#pragma unroll 1
                for (int i = 0; i < 2; ++i)
                    att::attn_unit(Fp, h, i ? s : 63 - s, P_BF(WS_Q), (const unsigned char*)(wsl + WS_K), (const unsigned char*)(wsl + WS_V8T), P_BF(WS_YAM), (const float*)(wsl + WS_TAB) + h * 128, lam, oml, L_PAR + PR_SUBG);
            }
            __builtin_amdgcn_s_setprio(0);
            SEAM_(pb + 2, true);
          }
        }
        if (IN(pb + 3) && (PHMASK >> 3 & 1)) { FRESH(Fp);
          _Pragma("unroll 1") for (int rep_ = 0; rep_ < 1 + ((REPMASK >> 3) & 1); ++rep_) {
            for (int u = Fp.vcu; u < 4 * mls::NC; u += Fp.G)
                mls::step1_unit(Fp, lq, u >> 7, u & 127, P_F32(WS_LF), P_F32(WS_IG), P_F32(WS_BC), P_F32(WS_AA), P_F32(WS_BL), P_F32(WS_ML), P_BF(WS_MQKR), P_BF(WS_MV), P_BF(WS_MQ), P_BF(WS_MK), L_PAR + PR_CONVW, L_PAR + PR_CONVB, P_BF(WS_UB), P_F32(WS_NU));
            SEAM(pb + 3);
          }
        }
        if (IN(pb + 4) && (PHMASK >> 4 & 1)) { FRESH(Fp);
            _Pragma("unroll 1") for (int rep_ = 0; rep_ < 1 + ((REPMASK >> 4) & 1); ++rep_) { if (Fp.vcu < 129 || lq + 1 >= DEPTH_) mls::scan_phase(Fp, P_BF(WS_UB), P_BF(WS_CST), P_F32(WS_BL), P_F32(WS_ML), P_F32(WS_MP), P_F32(WS_NU), P_F32(WS_NST));
                else wconv_layer(Fp, in, wsl + (((lq + 1) & 1) ? WS_W2 : WS_W), lq + 1, 129, (const float*)(wsl + WS_PAR) + (size_t)(lq + 1) * PAR_L, (const float*)(wsl + WS_MOD) + (lq + 1) * 6144, L_B1(lq + 1));
                SEAM(pb + 4);  }
        }
        if (IN(pb + 5) && (PHMASK >> 5 & 1)) { FRESH(Fp);
          _Pragma("unroll 1") for (int rep_ = 0; rep_ < 1 + ((REPMASK >> 5) & 1); ++rep_) {
            for (int u = Fp.vcu; u < 4 * mls::NC; u += Fp.G)
                mls::step3_unit(Fp, u >> 7, u & 127, P_BF(WS_MQ), P_BF(WS_MK), P_BF(WS_MV), P_BF(WS_CST), P_F32(WS_NST), P_F32(WS_MP), P_F32(WS_AA), P_F32(WS_BC), P_BF(WS_MO), L_PAR + PR_MHG, P_BF(WS_YAM));
            SEAM(pb + 5);
          }
        }
        if (IN(pb + 6) && (PHMASK >> 6 & 1)) { FRESH(Fp);
          _Pragma("unroll 1") for (int rep_ = 0; rep_ < 1 + ((REPMASK >> 6) & 1); ++rep_) {
            pg8::Gemm g{P_BF(WS_YAM), (const bf16*)(L_WL + W_A), S_, 1024, 2048, 2048, 2048}; pg8::StaticOrder So; So.init(S_, 1024, Fp.G, (int)blockIdx.x);
            pg8::EpiMerge E{P_BF(WS_XN), 1024, P_BF(WS_GAM), 2048};
            pg8::gemm_phase<pg8::EpiMerge, pg8::StaticOrder, true, true>(Fp.lds, g, So, E, Fp.wave);
            SEAM(pb + 7);
          }
        }
        if (IN(pb + 8) && (PHMASK >> 8 & 1)) { FRESH(Fp);
          _Pragma("unroll 1") for (int rep_ = 0; rep_ < 1 + ((REPMASK >> 8) & 1); ++rep_) {
            { const int gt = Fp.vcu * 512 + Fp.tid; if (gt < 4096) P_F32(WS_B1F)[gt] = fx_dec(L_B1(lq)[gt], 1.0f / B1Q_); }
            pg8::Gemm g{P_BF(WS_XN), (const bf16*)(L_WL + W_OUT), S_, 1024, 1024, 1024, 1024}; pg8::StaticOrder So; So.init(S_, 1024, Fp.G, (int)blockIdx.x);
            pg8::EpiResid<true> E{L_XSRC, xout, 1024, L_MOD + 2048, P_BF(WS_XB), (u64*)(wsl + WS_SS)};
            pg8::gemm_phase<pg8::EpiResid<true>, pg8::StaticOrder, true, true>(Fp.lds, g, So, E, Fp.wave);
            SEAM(pb + 9);
          }
        }
        if (IN(pb + 10) && (PHMASK >> 10 & 1)) { FRESH(Fp);
          _Pragma("unroll 1") for (int rep_ = 0; rep_ < 1 + ((REPMASK >> 10) & 1); ++rep_) {
            pg8::Gemm g{P_BF(WS_XB), (const bf16*)(L_WL + W_F1), S_, DFF_, 1024, 1024, 1024}; pg8::StaticOrder So; So.init(S_, DFF_, Fp.G, (int)blockIdx.x);
            pg8::EpiRelu2 E{P_BF(WS_FFU), DFF_, (u64*)(wsl + WS_SS), P_F32(WS_B1F)};
            pg8::gemm_phase<pg8::EpiRelu2, pg8::StaticOrder, true, true>(Fp.lds, g, So, E, Fp.wave);
            SEAM(pb + 10);
          }
        }
        if (IN(pb + 11) && (PHMASK >> 11 & 1)) { FRESH(Fp);
          _Pragma("unroll 1") for (int rep_ = 0; rep_ < 1 + ((REPMASK >> 11) & 1); ++rep_) {
            pg8::Gemm g{P_BF(WS_FFU), (const bf16*)(L_WL + W_F2), S_, 1024, DFF_, DFF_, DFF_}; pg8::StaticOrder So; So.init(S_, 1024, Fp.G, (int)blockIdx.x);
            pg8::EpiResid<false> E{xout, xout, 1024, L_MOD + 5120, nullptr, nullptr};
            pg8::gemm_phase<pg8::EpiResid<false>, pg8::StaticOrder, true, true>(Fp.lds, g, So, E, Fp.wave);
            SEAM(pb + 11);
          }
        }
    }
#undef IN
#undef SEAM
}

#ifndef MK_ONE_LAUNCH
#define MK_ONE_LAUNCH 1
#endif
extern "C" void kernel_launch(void* const* d_in, const int* in_sizes, int n_in, void* d_out, int out_size, void* d_ws, size_t ws_size, hipStream_t stream) {
    constexpr int grid = 256;
    static int once = 0;
    if (!once) { once = 1; (void)hipFuncSetAttribute((const void*)fwd, hipFuncAttributeMaxDynamicSharedMemorySize, LDS_BYTES); }
    if (ws_size < WS_END || n_in != 22) return;
    (void)hipMemsetAsync((char*)d_ws + WS_CTL, 0, CTL_ZERO_BYTES, stream);
    Args a{};
    for (int i = 0; i < 22; ++i) a.in[i] = (const float*)d_in[i];
    a.out = (float*)d_out; a.ws = (unsigned char*)d_ws;
#if MK_ONE_LAUNCH
    a.ph_lo = 0; a.ph_hi = NPHASES;
    hipLaunchKernelGGL(fwd, dim3(grid), dim3(512), LDS_BYTES, stream, a);
#else
    for (int p = 0; p < NPHASES; ++p) { a.ph_lo = p; a.ph_hi = p + 1; hipLaunchKernelGGL(fwd, dim3(grid), dim3(512), LDS_BYTES, stream, a); }
#endif
}
```

```cpp
#include <hip/hip_runtime.h>
#include <cstdio>
#include <cstdint>
#include <cmath>

constexpr int S_ = 16384, DM_ = 1024, DEPTH_ = 4, NIN_SRC = 9224, NIN_ = 9216, GATE_COL = 7168, DFF_ = 4096;
constexpr float EPS_ = 1e-6f;
constexpr float LOG2E_ = 1.4426950408889634f;
constexpr float C2Q_ = 0.125f * 1.4426950408889634f;

constexpr size_t EP_Q = 80u << 20, EP_K = 112u << 20, EP_V8T = 128u << 20, EP_V = 144u << 20, EP_MQKR = 176u << 20, EP_MV = 240u << 20, EP_MO = 272u << 20, EP_GAM = 304u << 20;

#ifndef DBG_ATT_SCALE
#define DBG_ATT_SCALE 1.0f
#endif
#ifndef DBG_MLS_SCALE
#define DBG_MLS_SCALE 1.0f
#endif
__device__ __forceinline__ int lane_id_opaque() { int l; asm volatile("v_mbcnt_lo_u32_b32 %0, -1, 0\n\tv_mbcnt_hi_u32_b32 %0, -1, %0" : "=v"(l)); return l; }
template <int M> __device__ __forceinline__ float swz_xor(float v) { static_assert(M >= 1 && M < 32, "xor inside a 32-lane half"); return __uint_as_float((unsigned)__builtin_amdgcn_ds_swizzle((int)__float_as_uint(v), (M << 10) | 0x1f)); }
__device__ __forceinline__ void halves(float v, float& lo, float& hi) { auto rr = __builtin_amdgcn_permlane32_swap(__float_as_uint(v), __float_as_uint(v), false, false); lo = __uint_as_float(rr[0]); hi = __uint_as_float(rr[1]); }
__device__ __forceinline__ float bperm(float v, int src_lane) { return __uint_as_float((unsigned)__builtin_amdgcn_ds_bpermute(src_lane << 2, (int)__float_as_uint(v))); }
typedef unsigned long long u64;
constexpr float SSQ_ = 16777216.0f, B1Q_ = 4294967296.0f;
__device__ __forceinline__ u64 zero64_opaque() { unsigned z = 0u; asm volatile("" : "+v"(z)); return ((u64)z << 32) | z; }
__device__ __forceinline__ u64 fx_enc(float v, float q) { return (u64)(long long)(v * q); }
__device__ __forceinline__ float fx_dec(u64 v, float iq) { return (float)(long long)v * iq; }
__device__ __forceinline__ float fx_dec_ss(u64 v) { return (float)(unsigned)(v >> 32) * 256.0f + (float)(unsigned)v * (1.0f / SSQ_); }
__device__ __forceinline__ float ubf(unsigned w, int k) { return (float)((w >> (8 * k)) & 0xffu); }
#ifndef PROJ8
#define PROJ8 1
#endif
#ifndef P8_LO
#define P8_LO 12
#endif
#ifndef P8_HI
#define P8_HI 12
#endif
constexpr unsigned long long PROJ8_TILES = PROJ8 ? (((1ull << 36) - 1) & ~(((1ull << P8_HI) - 1) & ~((1ull << P8_LO) - 1))) : 0ull;
#ifndef EMU8
#define EMU8 0
#endif
__device__ __forceinline__ float r8f(float x, float s) { const int w = __builtin_amdgcn_cvt_pk_fp8_f32(x * s, 0.f, 0, false); return __builtin_amdgcn_cvt_f32_fp8(w, 0) * (1.0f / s); }

namespace pg8 {
#define PG8_LAS __attribute__((address_space(3)))
typedef unsigned short bf16_t;
typedef short bf16x8 __attribute__((ext_vector_type(8)));
typedef float f32x4 __attribute__((ext_vector_type(4)));
typedef unsigned u32x4 __attribute__((ext_vector_type(4)));
typedef int i32x8g __attribute__((ext_vector_type(8)));
typedef int i32x4g __attribute__((ext_vector_type(4)));
constexpr int BM = 256, BK = 64, HALF = 128, HTB = HALF * BK * 2  , STAGE_BYTES = 8 * HTB, NXCD = 8, WGM = 8;

__host__ __device__ __forceinline__ int lds_byte(int r, int c) { const int st = (r >> 4) * 2 + (c >> 5), rr = r & 15, cc = c & 31, ob = rr * 64 + cc * 2; return st * 1024 + (ob ^ (((ob >> 9) & 1) << 5)); }
__host__ __device__ __forceinline__ void stage_rc(int b, int& R, int& C) { const int st = b / 1024, sb = b % 1024, swz = sb ^ (((sb >> 9) & 1) << 5); R = (st >> 1) * 16 + swz / 64; C = (st & 1) * 32 + (swz % 64) / 2; }
__host__ __device__ __forceinline__ int perm32(int rho) { const int n = rho >> 4, i = rho & 15; return 8 * (i >> 2) + 4 * n + (i & 3); }

struct Unit { int pm, pn; };
struct Gemm { const bf16_t* A; const bf16_t* Bt; int M, N, K, lda, ldb; };

struct StaticOrder {
    int nM, nN, nwg, G, c;
    __host__ __device__ void init(int M, int N, int G_, int c_) { nM = M / BM; nN = N / BM; nwg = nM * nN; G = G_; c = c_; }
    __host__ __device__ bool next(int i, Unit& u) const {
        const long L = (long)i * G + c; if (L >= nwg) return false;
        int wgid = (int)L; { const int q = nwg / NXCD, r = nwg % NXCD, xcd = wgid % NXCD, off = wgid / NXCD; wgid = (xcd < r ? xcd * (q + 1) : r * (q + 1) + (xcd - r) * q) + off; }
        const int nig = WGM * nN, gid = wgid / nig, fm = gid * WGM, gsz = (nM - fm) < WGM ? (nM - fm) : WGM;
        u.pm = fm + ((wgid % nig) % gsz); u.pn = (wgid % nig) / gsz; return true;
    }
    __device__ __forceinline__ void a_ready(const Unit&) const {}
    __device__ __forceinline__ void done(const Unit&) const {}
};
template <int SPLIT, int SKIP> struct SubsetOrder : StaticOrder {
    __host__ __device__ bool next(int i, Unit& u) const { if (!StaticOrder::next(i, u)) return false; if (u.pn >= SPLIT) u.pn += SKIP; return true; }
};

__device__ __forceinline__ unsigned cvt_pk_bf16(float lo, float hi) { unsigned r; asm volatile("v_cvt_pk_bf16_f32 %0, %1, %2" : "=v"(r) : "v"(lo), "v"(hi)); return r; }
__device__ __forceinline__ float sigm(float x) { return __builtin_amdgcn_rcpf(1.0f + __expf(-x)); }
__device__ __forceinline__ float bflo(unsigned w) { return __uint_as_float(w << 16); }
__device__ __forceinline__ float bfhi(unsigned w) { return __uint_as_float(w & 0xffff0000u); }
__device__ __forceinline__ u32x4 pack8(const f32x4 v0, const f32x4 v1) { u32x4 w; w.x = cvt_pk_bf16(v0[0], v0[1]); w.y = cvt_pk_bf16(v0[2], v0[3]); w.z = cvt_pk_bf16(v1[0], v1[1]); w.w = cvt_pk_bf16(v1[2], v1[3]); return w; }

struct EpiProj {
    static constexpr bool PERM = true, AFTER_DRAIN = false, MIDK = false;
    unsigned char* ws; const float *qg, *kg;
    __device__ __forceinline__ void operator()(const f32x4 (&acc)[2][2][4][2], const Unit& u, int wr, int wc, int fr_in, int fq_in) const {
        int fr = fr_in, fq = fq_in; asm volatile("" : "+v"(fr), "+v"(fq));
        const int pn = u.pn; const int row0 = u.pm * BM + wr * 64 + fr;
        if (pn < 8) {
            const bool isq = pn < 4; const float* g = isq ? qg : kg; const float sc = isq ? 8.0f * C2Q_ : 1.0f;
            f32x4 gv[2][2];
#pragma unroll
            for (int bj = 0; bj < 2; ++bj)
#pragma unroll
                for (int n = 0; n < 2; ++n) gv[bj][n] = *(const f32x4*)(g + 32 * bj + 8 * fq + 4 * n);
            unsigned char* qbase = ws + EP_Q + (pn & 3) * 256 + 64 * wc + 8 * fq;
            unsigned char* kbase = ws + EP_K + (pn & 3) * 256 + 64 * wc + (fq & 1) * 32 + (fq >> 1) * 8;
#pragma unroll
            for (int ai = 0; ai < 2; ++ai)
#pragma unroll
                for (int m = 0; m < 4; ++m) {
                    float ss = 0.f;
#pragma unroll
                    for (int bj = 0; bj < 2; ++bj)
#pragma unroll
                        for (int n = 0; n < 2; ++n) { const f32x4 x = acc[ai][bj][m][n]; ss += (x[0] * x[0] + x[1] * x[1]) + (x[2] * x[2] + x[3] * x[3]); }
                    ss += swz_xor<16>(ss); { float lo_, hi_; halves(ss, lo_, hi_); ss = lo_ + hi_; }
                    const float r = sc / sqrtf(ss * (1.0f / 64.0f) + EPS_);
                    const size_t row = (size_t)(row0 + ai * HALF + m * 16);
#pragma unroll
                    for (int bj = 0; bj < 2; ++bj) { const f32x4 v0 = acc[ai][bj][m][0] * r * gv[bj][0], v1 = acc[ai][bj][m][1] * r * gv[bj][1];
                        int lo = 0, hi4 = 0; lo = __builtin_amdgcn_cvt_pk_fp8_f32(v0[0], v0[1], lo, false); lo = __builtin_amdgcn_cvt_pk_fp8_f32(v0[2], v0[3], lo, true);
                        hi4 = __builtin_amdgcn_cvt_pk_fp8_f32(v1[0], v1[1], hi4, false); hi4 = __builtin_amdgcn_cvt_pk_fp8_f32(v1[2], v1[3], hi4, true);
                        typedef int i32x2 __attribute__((ext_vector_type(2)));
                        if (isq) *(i32x2*)(qbase + row * 1024 + 32 * bj) = (i32x2){lo, hi4}; else *(i32x2*)(kbase + row * 1024 + 16 * bj) = (i32x2){lo, hi4}; }
                }
        } else if (pn < 12) {
            const int a = (fr >> 2) & 3, j = fr & 3;
            const unsigned selj = 0x0c0c0000u | ((4u + (unsigned)j) << 8) | (unsigned)j;
            unsigned char* vb = ws + EP_V8T + ((size_t)(2 * (pn - 8)) * 256 + (size_t)(u.pm * 4 + wr)) * 8192 + (size_t)(wc * 32 + 8 * fq + j) * 64 + (a & 1) * 32 + (a >> 1) * 4;
#pragma unroll
            for (int ai = 0; ai < 2; ++ai)
#pragma unroll
                for (int m = 0; m < 4; ++m)
#pragma unroll
                    for (int bj = 0; bj < 2; ++bj)
#pragma unroll
                        for (int n = 0; n < 2; ++n) { const f32x4 x = acc[ai][bj][m][n];
                            int w = __builtin_amdgcn_cvt_pk_fp8_f32(x[0], x[1], 0, false); w = __builtin_amdgcn_cvt_pk_fp8_f32(x[2], x[3], w, true);
                            const int l0 = __builtin_amdgcn_mov_dpp(w, 0x00, 0xf, 0xf, true), l1 = __builtin_amdgcn_mov_dpp(w, 0x55, 0xf, 0xf, true), l2 = __builtin_amdgcn_mov_dpp(w, 0xaa, 0xf, 0xf, true), l3 = __builtin_amdgcn_mov_dpp(w, 0xff, 0xf, 0xf, true);
                            const unsigned t01 = __builtin_amdgcn_perm((unsigned)l1, (unsigned)l0, selj), t23 = __builtin_amdgcn_perm((unsigned)l3, (unsigned)l2, selj);
                            const unsigned tt = __builtin_amdgcn_perm(t23, t01, 0x05040100u);
                            *(unsigned*)(vb + ((size_t)bj * 256 + (size_t)ai * 2) * 8192 + (size_t)(4 * n) * 64 + (m >> 1) * 16 + (m & 1) * 8) = tt; }
        } else {
            bf16_t* base; int ldc, c0; bool sg;
            if (pn < 20) { base = (bf16_t*)(ws + EP_MQKR); ldc = 2048; c0 = (pn - 12) * 256; sg = false; }
            else if (pn < 24) { base = (bf16_t*)(ws + EP_MV); ldc = 1024; c0 = (pn - 20) * 256; sg = false; }
            else if (pn < 28) { base = (bf16_t*)(ws + EP_MO); ldc = 1024; c0 = (pn - 24) * 256; sg = true; }
            else { base = (bf16_t*)(ws + EP_GAM); ldc = 2048; c0 = (pn - 28) * 256; sg = true; }
            const int col0 = c0 + wc * 32 + 8 * fq;
#pragma unroll
            for (int ai = 0; ai < 2; ++ai)
#pragma unroll
                for (int m = 0; m < 4; ++m) { bf16_t* rowp = base + (size_t)(row0 + ai * HALF + m * 16) * ldc + col0;
#pragma unroll
                    for (int bj = 0; bj < 2; ++bj) { f32x4 v0 = acc[ai][bj][m][0], v1 = acc[ai][bj][m][1];
                        if (sg && pn < 28) {
                            unsigned w0 = 0u, w1 = 0u;
#pragma unroll
                            for (int i = 0; i < 4; ++i) { w0 |= (unsigned)(sigm(v0[i]) * 255.0f + 0.5f) << (8 * i); w1 |= (unsigned)(sigm(v1[i]) * 255.0f + 0.5f) << (8 * i); }
                            typedef unsigned u32x2g __attribute__((ext_vector_type(2)));
                            *(u32x2g*)((unsigned char*)base + (size_t)(row0 + ai * HALF + m * 16) * ldc + col0 + bj * HALF) = (u32x2g){w0, w1}; }
                        else { if (sg) {
#pragma unroll
                            for (int i = 0; i < 4; ++i) { v0[i] = sigm(v0[i]); v1[i] = sigm(v1[i]); } }
                          *(u32x4*)(rowp + bj * HALF) = pack8(v0, v1); } } }
        }
    }
};
struct EpiRelu2 {
    static constexpr bool PERM = true, AFTER_DRAIN = false, MIDK = false;
    bf16_t* O; int ldc; const u64* SS; const float* b1;
    __device__ __forceinline__ void operator()(const f32x4 (&acc)[2][2][4][2], const Unit& u, int wr, int wc, int fr, int fq) const {
        const int row0 = u.pm * BM + wr * 64 + fr, col0 = u.pn * BM + wc * 32 + 8 * fq;
        f32x4 bv[2][2];
#pragma unroll
        for (int bj = 0; bj < 2; ++bj)
#pragma unroll
            for (int n = 0; n < 2; ++n) bv[bj][n] = *(const f32x4*)(b1 + col0 + bj * HALF + 4 * n);
#pragma unroll
        for (int ai = 0; ai < 2; ++ai)
#pragma unroll
            for (int m = 0; m < 4; ++m) { const int row = row0 + ai * HALF + m * 16; const float r = __builtin_amdgcn_rsqf(fx_dec_ss(SS[row]) * (1.0f / 1024.0f) + EPS_);
                bf16_t* rowp = O + (size_t)row * ldc + col0;
#pragma unroll
                for (int bj = 0; bj < 2; ++bj) { f32x4 v0 = acc[ai][bj][m][0] * r + bv[bj][0], v1 = acc[ai][bj][m][1] * r + bv[bj][1];
#pragma unroll
                    for (int i = 0; i < 4; ++i) { const float a = fmaxf(v0[i], 0.f), b = fmaxf(v1[i], 0.f); v0[i] = a * a; v1[i] = b * b; if (EMU8 & 4) { v0[i] = r8f(v0[i], 1.f); v1[i] = r8f(v1[i], 1.f); } }
                    *(u32x4*)(rowp + bj * HALF) = pack8(v0, v1); } }
    }
};
struct EpiMerge {
    static constexpr bool PERM = true, AFTER_DRAIN = false, MIDK = true;
    bf16_t* O; int ldc; const bf16_t* G; int ldg;
    static __device__ __forceinline__ float g2c(float g) { return fmaxf(g, 9.094947e-13f); }
    __device__ __forceinline__ void mid(f32x4 (&acc)[2][2][4][2], const Unit& u, int wr, int wc, int fr, int fq) const {
        const int row0 = u.pm * BM + wr * 64 + fr, col0 = u.pn * BM + wc * 32 + 8 * fq;
#pragma unroll
        for (int g = 0; g < 8; ++g) { const int ai = g >> 2, m = g & 3; const size_t r = (size_t)(row0 + ai * HALF + m * 16);
#pragma unroll
            for (int bj = 0; bj < 2; ++bj) { const u32x4 q1 = *(const u32x4*)(G + r * ldg + col0 + bj * HALF), q2 = *(const u32x4*)(G + r * ldg + 1024 + col0 + bj * HALF);
                f32x4& v0 = acc[ai][bj][m][0]; f32x4& v1 = acc[ai][bj][m][1];
                v0[0] *= bflo(q1.x) * __builtin_amdgcn_rcpf(g2c(bflo(q2.x))); v0[1] *= bfhi(q1.x) * __builtin_amdgcn_rcpf(g2c(bfhi(q2.x))); v0[2] *= bflo(q1.y) * __builtin_amdgcn_rcpf(g2c(bflo(q2.y))); v0[3] *= bfhi(q1.y) * __builtin_amdgcn_rcpf(g2c(bfhi(q2.y)));
                v1[0] *= bflo(q1.z) * __builtin_amdgcn_rcpf(g2c(bflo(q2.z))); v1[1] *= bfhi(q1.z) * __builtin_amdgcn_rcpf(g2c(bfhi(q2.z))); v1[2] *= bflo(q1.w) * __builtin_amdgcn_rcpf(g2c(bflo(q2.w))); v1[3] *= bfhi(q1.w) * __builtin_amdgcn_rcpf(g2c(bfhi(q2.w))); } }
    }
    __device__ __forceinline__ void operator()(const f32x4 (&acc)[2][2][4][2], const Unit& u, int wr, int wc, int fr, int fq) const {
        const int row0 = u.pm * BM + wr * 64 + fr, col0 = u.pn * BM + wc * 32 + 8 * fq;
        u32x4 gw[2][2];
#define EG_LOAD(g_, b_) do { const size_t r_ = (size_t)(row0 + ((g_) >> 2) * HALF + ((g_) & 3) * 16); _Pragma("unroll") for (int bj = 0; bj < 2; ++bj) gw[b_][bj] = *(const u32x4*)(G + r_ * ldg + 1024 + col0 + bj * HALF); } while (0)
        EG_LOAD(0, 0);
#pragma unroll
        for (int g = 0; g < 8; ++g) { const int ai = g >> 2, m = g & 3, b = g & 1; const size_t r = (size_t)(row0 + ai * HALF + m * 16);
            if (g + 1 < 8) EG_LOAD(g + 1, (g + 1) & 1);
#pragma unroll
            for (int bj = 0; bj < 2; ++bj) { f32x4 v0 = acc[ai][bj][m][0], v1 = acc[ai][bj][m][1]; const u32x4 q = gw[b][bj];
                v0[0] *= g2c(bflo(q.x)); v0[1] *= g2c(bfhi(q.x)); v0[2] *= g2c(bflo(q.y)); v0[3] *= g2c(bfhi(q.y)); v1[0] *= g2c(bflo(q.z)); v1[1] *= g2c(bfhi(q.z)); v1[2] *= g2c(bflo(q.w)); v1[3] *= g2c(bfhi(q.w));
                *(u32x4*)(O + r * ldc + col0 + bj * HALF) = pack8(v0, v1); } }
#undef EG_LOAD
    }
};
template <bool STAT> struct EpiResid {
    static constexpr bool PERM = false, AFTER_DRAIN = false, MIDK = false;
    const float* xin; float* out; int ldc; const float* gate; bf16_t* XB; u64* SS;
    __device__ __forceinline__ void operator()(const f32x4 (&acc)[2][2][4][2], const Unit& u, int wr, int wc, int fr, int fq) const {
        const int row0 = u.pm * BM + wr * 64 + fr, col0 = u.pn * BM + wc * 32 + 4 * fq;
        f32x4 gv[2][2];
#pragma unroll
        for (int bj = 0; bj < 2; ++bj)
#pragma unroll
            for (int n = 0; n < 2; ++n) gv[bj][n] = *(const f32x4*)(gate + col0 + bj * HALF + n * 16);
        f32x4 xa[2][2][2];
#define ER_LOAD(g_, b_) do { const size_t o_ = (size_t)(row0 + ((g_) >> 2) * HALF + ((g_) & 3) * 16) * ldc + col0; _Pragma("unroll") for (int bj = 0; bj < 2; ++bj) _Pragma("unroll") for (int n = 0; n < 2; ++n) xa[b_][bj][n] = *(const f32x4*)(xin + o_ + bj * HALF + n * 16); } while (0)
        ER_LOAD(0, 0);
#pragma unroll
        for (int g = 0; g < 8; ++g) { const int ai = g >> 2, m = g & 3, b = g & 1; const int row = row0 + ai * HALF + m * 16; const size_t off = (size_t)row * ldc + col0; float ss = 0.f;
            if (g + 1 < 8) ER_LOAD(g + 1, (g + 1) & 1);
#pragma unroll
            for (int bj = 0; bj < 2; ++bj)
#pragma unroll
                for (int n = 0; n < 2; ++n) { const f32x4 y = xa[b][bj][n] + gv[bj][n] * acc[ai][bj][m][n];
                    *(f32x4*)(out + off + bj * HALF + n * 16) = y;
                    if (STAT) { ss += (y[0] * y[0] + y[1] * y[1]) + (y[2] * y[2] + y[3] * y[3]);
                        typedef unsigned u32x2 __attribute__((ext_vector_type(2))); u32x2 w; f32x4 yq = y; if (EMU8 & 2) { yq[0] = r8f(y[0], 1.f); yq[1] = r8f(y[1], 1.f); yq[2] = r8f(y[2], 1.f); yq[3] = r8f(y[3], 1.f); } w.x = cvt_pk_bf16(yq[0], yq[1]); w.y = cvt_pk_bf16(yq[2], yq[3]); *(u32x2*)(XB + off + bj * HALF + n * 16) = w; } }
            if (STAT) { ss += swz_xor<16>(ss); float lo_, hi_; halves(ss, lo_, hi_); ss = lo_ + hi_; if (fq == 0) atomicAdd(SS + row, fx_enc(ss, SSQ_)); } }
#undef ER_LOAD
    }
};

template <class Epi, class Sched, bool ALIGN_EPI = false, bool SP2 = false, bool F8 = false>
__device__ __forceinline__ void gemm_phase(PG8_LAS unsigned char* lds, const Gemm g, const Sched& S, const Epi& E, const int wid_in) {
    const int lane = lane_id_opaque(), wid = wid_in, tid = wid * 64 + lane;
    const int wr = wid >> 2, wc = wid & 3, fr = lane & 15, fq = lane >> 4;
    const int K = g.K, nt = K / BK;
    unsigned voffA, voffB;
    { int R, C; stage_rc(tid * 16, R, C); const int Rb = Epi::PERM ? ((R & ~31) + perm32(R & 31)) : R;
      voffA = (unsigned)(R * g.lda + C) * 2u; voffB = (unsigned)(Rb * g.ldb + C) * 2u; }
    const size_t d64A = (size_t)64 * g.lda * 2, d64B = (size_t)64 * g.ldb * 2;
    const size_t kstep = (size_t)(BK * 2);
    const size_t hstepA = (size_t)HALF * g.lda * 2, hstepB = (size_t)HALF * g.ldb * 2;
    const size_t tstepA = 2 * hstepA, tstepB = 2 * hstepB;
    const unsigned ldsw = (unsigned)wid * 1024u;
    const int aoff = lds_byte(wr * 64 + fr, fq * 8), boff = lds_byte(wc * 32 + fr, fq * 8);
#define PG8_SA(b, h) (((b) * 2 + (h)) * HTB)
#define PG8_SB(b, h) ((4 + (b) * 2 + (h)) * HTB)
#define PG8_STAGE(bufoff, gbase, voff) do { \
        __builtin_amdgcn_global_load_lds((const unsigned*)((const char*)(gbase) + (voff)), (PG8_LAS unsigned*)(lds + (bufoff) + ldsw), 16, 0, 0); \
        __builtin_amdgcn_global_load_lds((const unsigned*)((const char*)(gbase) + PG8_D64(voff) + (voff)), (PG8_LAS unsigned*)(lds + (bufoff) + ldsw + 8192), 16, 0, 0); } while (0)
#define PG8_D64(voff) PG8_D64_##voff
#define PG8_D64_voffA d64A
#define PG8_D64_voffB d64B
#define PG8_LD32(p) __builtin_shufflevector(*(const PG8_LAS i32x4g*)(p), *(const PG8_LAS i32x4g*)((p) + 1024), 0, 1, 2, 3, 4, 5, 6, 7)
#define PG8_LO(v) __builtin_bit_cast(bf16x8, __builtin_shufflevector(v, v, 0, 1, 2, 3))
#define PG8_HI(v) __builtin_bit_cast(bf16x8, __builtin_shufflevector(v, v, 4, 5, 6, 7))
#define PG8_LDA(dst, b, h) do { _Pragma("unroll") for (int m = 0; m < 4; ++m) dst[m] = PG8_LD32(lds + PG8_SA(b, h) + aoff + m * 2048); } while (0)
#define PG8_LDB(dst, b, h) do { _Pragma("unroll") for (int n = 0; n < 2; ++n) dst[n] = PG8_LD32(lds + PG8_SB(b, h) + boff + n * 2048); } while (0)
#define PG8_MMA(ai, bj, At, Bt) do { __builtin_amdgcn_s_setprio(1); _Pragma("unroll") for (int m = 0; m < 4; ++m) _Pragma("unroll") for (int n = 0; n < 2; ++n) { \
        if constexpr (F8) asm volatile("v_mfma_scale_f32_16x16x128_f8f6f4 %0, %1, %2, %0, %3, %3 op_sel_hi:[0,0,0]" : "+v"(acc[ai][bj][m][n]) : "v"(Bt[n]), "v"(At[m]), "v"(sc8)); \
        else { acc[ai][bj][m][n] = __builtin_amdgcn_mfma_f32_16x16x32_bf16(PG8_LO(Bt[n]), PG8_LO(At[m]), acc[ai][bj][m][n], 0, 0, 0); \
               acc[ai][bj][m][n] = __builtin_amdgcn_mfma_f32_16x16x32_bf16(PG8_HI(Bt[n]), PG8_HI(At[m]), acc[ai][bj][m][n], 0, 0, 0); } } __builtin_amdgcn_s_setprio(0); } while (0)
#define PG8_WAIT_V(n) asm volatile("s_waitcnt vmcnt(" #n ")" ::: "memory")
#define PG8_WAIT_L(n) asm volatile("s_waitcnt lgkmcnt(" #n ")" ::: "memory")
#define PG8_BAR __builtin_amdgcn_s_barrier()
#define PG8_SCHED __builtin_amdgcn_sched_barrier(0)
    Unit cur, nxt; int ui = 0;
    if (!S.next(0, cur)) return;
    f32x4 acc[2][2][4][2];
#pragma unroll
    for (int a = 0; a < 2; ++a)
#pragma unroll
        for (int b = 0; b < 2; ++b)
#pragma unroll
            for (int m = 0; m < 4; ++m)
#pragma unroll
                for (int n = 0; n < 2; ++n) acc[a][b][m][n] = (f32x4){0.f, 0.f, 0.f, 0.f};
    i32x8g At[4], B0[2], B1[2];
    int sc8 = 0x7c; asm volatile("" : "+v"(sc8));
    const char* cA = (const char*)g.A + (size_t)cur.pm * tstepA; const char* cB = (const char*)g.Bt + (size_t)cur.pn * tstepB;
    S.a_ready(cur);
    if constexpr (SP2) {
        PG8_STAGE(PG8_SB(0, 0), cB, voffB); PG8_STAGE(PG8_SB(0, 1), cB + hstepB, voffB); PG8_STAGE(PG8_SA(0, 0), cA, voffA); PG8_STAGE(PG8_SA(0, 1), cA + hstepA, voffA);
        PG8_STAGE(PG8_SB(1, 0), cB + kstep, voffB); PG8_STAGE(PG8_SA(1, 0), cA + kstep, voffA); PG8_STAGE(PG8_SB(1, 1), cB + hstepB + kstep, voffB);
        if (wr == 1) PG8_BAR;
        PG8_WAIT_V(8); PG8_BAR;
        PG8_WAIT_V(6); PG8_BAR;
    } else {
        PG8_STAGE(PG8_SB(0, 0), cB, voffB); PG8_STAGE(PG8_SA(0, 0), cA, voffA); PG8_STAGE(PG8_SB(0, 1), cB + hstepB, voffB); PG8_STAGE(PG8_SA(0, 1), cA + hstepA, voffA);
        if (wr == 1) PG8_BAR;
        PG8_WAIT_V(4); PG8_BAR;
        PG8_STAGE(PG8_SB(1, 0), cB + kstep, voffB); PG8_STAGE(PG8_SA(1, 0), cA + kstep, voffA); PG8_STAGE(PG8_SB(1, 1), cB + hstepB + kstep, voffB);
        PG8_WAIT_V(6); PG8_BAR;
    }
    for (;;) {
        const bool has_next = S.next(ui + 1, nxt);
        const char* nA = has_next ? (const char*)g.A + (size_t)nxt.pm * tstepA : cA; const char* nB = has_next ? (const char*)g.Bt + (size_t)nxt.pn * tstepB : cB;
#pragma unroll 1
        for (int t = 0; t < nt; t += 2) {
            if constexpr (Epi::MIDK) { if (t == nt / 2) { const int lm = lane_id_opaque(); E.mid(acc, cur, wr, wc, lm & 15, lm >> 4); } }
            const bool last = (t == nt - 2);
            const char* a1 = cA + (size_t)(t + 1) * kstep;
            const char* a2 = last ? nA : cA + (size_t)(t + 2) * kstep; const char* b2 = last ? nB : cB + (size_t)(t + 2) * kstep;
            const char* a3 = a2 + kstep; const char* b3 = b2 + kstep;
            if (last && has_next) S.a_ready(nxt);
            if constexpr (SP2) {
            PG8_LDB(B0, 0, 0); PG8_LDB(B1, 0, 1); PG8_SCHED; PG8_LDA(At, 0, 0); PG8_STAGE(PG8_SA(1, 1), a1 + hstepA, voffA);
            PG8_WAIT_V(8); PG8_WAIT_L(0); PG8_BAR; PG8_MMA(0, 0, At, B0); PG8_MMA(0, 1, At, B1); PG8_BAR; PG8_SCHED;
            PG8_LDA(At, 0, 1); PG8_STAGE(PG8_SB(0, 0), b2, voffB); PG8_STAGE(PG8_SB(0, 1), b2 + hstepB, voffB); PG8_STAGE(PG8_SA(0, 0), a2, voffA);
            PG8_WAIT_V(8); PG8_WAIT_L(0); PG8_BAR; PG8_MMA(1, 0, At, B0); PG8_MMA(1, 1, At, B1); PG8_BAR; PG8_SCHED;
            PG8_LDB(B0, 1, 0); PG8_LDB(B1, 1, 1); PG8_SCHED; PG8_LDA(At, 1, 0); PG8_STAGE(PG8_SA(0, 1), a2 + hstepA, voffA);
            PG8_WAIT_V(8); PG8_WAIT_L(0); PG8_BAR; PG8_MMA(0, 0, At, B0); PG8_MMA(0, 1, At, B1); PG8_BAR; PG8_SCHED;
            PG8_LDA(At, 1, 1); PG8_STAGE(PG8_SB(1, 0), b3, voffB); PG8_STAGE(PG8_SB(1, 1), b3 + hstepB, voffB); PG8_STAGE(PG8_SA(1, 0), a3, voffA);
            PG8_WAIT_V(8); PG8_WAIT_L(0); PG8_BAR; PG8_MMA(1, 0, At, B0); PG8_MMA(1, 1, At, B1); PG8_BAR; PG8_SCHED;
            } else {
            PG8_LDB(B0, 0, 0); PG8_SCHED; PG8_LDA(At, 0, 0); PG8_STAGE(PG8_SA(1, 1), a1 + hstepA, voffA);
            PG8_WAIT_L(8); PG8_BAR; PG8_WAIT_L(0); PG8_MMA(0, 0, At, B0); PG8_BAR; PG8_SCHED;
            PG8_LDB(B1, 0, 1); PG8_STAGE(PG8_SB(0, 0), b2, voffB);
            PG8_BAR; PG8_WAIT_L(0); PG8_MMA(0, 1, At, B1); PG8_BAR;
            PG8_LDA(At, 0, 1); PG8_STAGE(PG8_SA(0, 0), a2, voffA);
            PG8_BAR; PG8_WAIT_L(0); PG8_MMA(1, 0, At, B0); PG8_BAR; PG8_SCHED;
            PG8_STAGE(PG8_SB(0, 1), b2 + hstepB, voffB);
            PG8_WAIT_V(6); PG8_BAR; PG8_MMA(1, 1, At, B1); PG8_BAR;
            PG8_LDB(B0, 1, 0); PG8_SCHED; PG8_LDA(At, 1, 0); PG8_STAGE(PG8_SA(0, 1), a2 + hstepA, voffA);
            PG8_WAIT_L(8); PG8_BAR; PG8_WAIT_L(0); PG8_MMA(0, 0, At, B0); PG8_BAR; PG8_SCHED;
            PG8_LDB(B1, 1, 1); PG8_STAGE(PG8_SB(1, 0), b3, voffB);
            PG8_BAR; PG8_WAIT_L(0); PG8_MMA(0, 1, At, B1); PG8_BAR;
            PG8_LDA(At, 1, 1); PG8_STAGE(PG8_SA(1, 0), a3, voffA);
            PG8_BAR; PG8_WAIT_L(0); PG8_MMA(1, 0, At, B0); PG8_BAR; PG8_SCHED;
            PG8_STAGE(PG8_SB(1, 1), b3 + hstepB, voffB);
            PG8_WAIT_V(6); PG8_BAR; PG8_MMA(1, 1, At, B1); PG8_BAR;
            }
        }
        if constexpr (F8) asm volatile("s_nop 15\n\ts_nop 15" ::: "memory");
        if constexpr (ALIGN_EPI) { if (wr == 0) PG8_BAR; }
        if constexpr (!Epi::AFTER_DRAIN) { const int le = lane_id_opaque(); E(acc, cur, wr, wc, le & 15, le >> 4); S.done(cur); }
        if (!has_next) break;
#pragma unroll
        for (int a = 0; a < 2; ++a)
#pragma unroll
            for (int b = 0; b < 2; ++b)
#pragma unroll
                for (int m = 0; m < 4; ++m)
#pragma unroll
                    for (int n = 0; n < 2; ++n) acc[a][b][m][n] = (f32x4){0.f, 0.f, 0.f, 0.f};
        cur = nxt; cA = nA; cB = nB; ++ui;
        if constexpr (ALIGN_EPI) { if (wr == 1) PG8_BAR; }
    }
    PG8_WAIT_V(0);
    if constexpr (!ALIGN_EPI) { if (wr == 0) PG8_BAR; }
    PG8_BAR;
    if constexpr (Epi::AFTER_DRAIN) { E.fused(acc, cur, wr, wc, fr, fq, lds, wid, lane); S.done(cur); }
#undef PG8_SA
#undef PG8_SB
#undef PG8_STAGE
#undef PG8_D64
#undef PG8_D64_voffA
#undef PG8_D64_voffB
#undef PG8_LDA
#undef PG8_LDB
#undef PG8_MMA
#undef PG8_LD32
#undef PG8_LO
#undef PG8_HI
#undef PG8_WAIT_V
#undef PG8_WAIT_L
#undef PG8_BAR
#undef PG8_SCHED
}
}

constexpr size_t MiB = 1u << 20;
constexpr size_t WS_CTL = 0, CTL_ZERO_BYTES = 64 * 1024;
constexpr size_t WS_MODP = 1 * MiB;
constexpr size_t WS_MOD = 3 * MiB;
constexpr size_t WS_TAB = 3 * MiB + 512 * 1024;
constexpr size_t WS_IG = 4 * MiB;
constexpr size_t WS_LF = WS_IG + 256 * 1024, WS_BC = WS_LF + 256 * 1024, WS_AA = WS_BC + 256 * 1024;
constexpr size_t WS_CHK = 5 * MiB;
constexpr size_t WS_BL = WS_CHK, WS_ML = WS_CHK + 4096, WS_MP = WS_CHK + 8192;
constexpr size_t WS_NU = 5 * MiB + 64 * 1024;
constexpr size_t WS_NST = WS_NU + 512 * 1024;
constexpr size_t WS_PAR = 7 * MiB;
constexpr int PAR_L = 21008, PR_NMG = 0, PR_NFG = 1024, PR_QNG = 2048, PR_KNG = 2112, PR_SUBG = 2176, PR_MHG = 2304, PR_BIG = 2560, PR_BFG = 2564, PR_CONVB = 2576, PR_CONVW = 4624, PR_GW = 12816;
constexpr size_t WS_SS = 7 * MiB + 512 * 1024;
constexpr size_t WS_B1 = 7 * MiB + 640 * 1024;
constexpr size_t WS_B1F = WS_B1 + 2 * 4096 * 8;
static_assert(WS_B1F + 4096 * 4 <= 8 * MiB, "B1F");
constexpr size_t WS_W = 8 * MiB;
constexpr size_t W_IN = 0, W_A = 18 * MiB, W_M = 20 * MiB, W_OUT = 22 * MiB, W_F1 = 24 * MiB, W_F2 = 32 * MiB;
constexpr size_t WS_XN = 48 * MiB;
constexpr size_t WS_MK = WS_XN;
constexpr size_t WS_Q = 80 * MiB, WS_K = 112 * MiB;
constexpr size_t WS_UB = WS_Q;
constexpr size_t WS_V8T = WS_K + 16 * MiB;
constexpr size_t WS_V = 144 * MiB;
constexpr size_t WS_MQ = WS_V;
constexpr size_t WS_FFU = WS_Q;
constexpr size_t WS_MQKR = 176 * MiB;
constexpr size_t WS_CST = WS_MQKR;
constexpr size_t WS_MV = 240 * MiB, WS_MO = 272 * MiB;
constexpr size_t WS_GAM = 304 * MiB;
constexpr size_t WS_YAM = 368 * MiB;
constexpr size_t WS_XB = WS_YAM;
constexpr size_t WS_W2 = 432 * MiB;
constexpr size_t WS_END = 472 * MiB;
static_assert(WS_SS + (size_t)S_ * 8 <= WS_B1 && WS_B1 + 2 * 4096 * 8 <= WS_W && WS_PAR + (size_t)DEPTH_ * PAR_L * 4 <= WS_SS && WS_NST + 512 * 1024 <= WS_PAR && WS_PAR + (size_t)DEPTH_ * PAR_L * 4 <= WS_W && WS_MODP + 16 * 24576 * 4 <= WS_MOD && WS_MOD + 24576 * 4 <= WS_TAB && WS_AA + 256 * 1024 <= WS_CHK && WS_MP + 4096 <= WS_NU, "small-region map");
static_assert(EP_Q == WS_Q && EP_K == WS_K && EP_V8T == WS_V8T && EP_V == WS_V && EP_MQKR == WS_MQKR && EP_MV == WS_MV && EP_MO == WS_MO && EP_GAM == WS_GAM, "projection epilogue offsets");

constexpr int LDS_BYTES = 147456;
constexpr int MISC_OFF = LDS_BYTES - 256;

#define GAS __attribute__((address_space(1)))
#define LAS __attribute__((address_space(3)))
typedef unsigned short bf16;
typedef unsigned v4u __attribute__((ext_vector_type(4)));
typedef unsigned v2u __attribute__((ext_vector_type(2)));
typedef float f32x4 __attribute__((ext_vector_type(4)));
typedef float f32x16 __attribute__((ext_vector_type(16)));
typedef short bf16x8 __attribute__((ext_vector_type(8)));
typedef short s16x4 __attribute__((ext_vector_type(4)));
typedef GAS unsigned gu32;
#define RLX_AGENT __ATOMIC_RELAXED, __HIP_MEMORY_SCOPE_AGENT
#define LDS_WAIT() asm volatile("s_waitcnt lgkmcnt(0)" ::: "memory")
#define VM_WAIT() asm volatile("s_waitcnt vmcnt(0)" ::: "memory")
__device__ __forceinline__ unsigned pk2(float lo, float hi) { return pg8::cvt_pk_bf16(lo, hi); }
__device__ __forceinline__ float bf2f(bf16 b) { return __uint_as_float((unsigned)b << 16); }
__device__ __forceinline__ bf16 f2bf(float f) { return (bf16)(pg8::cvt_pk_bf16(f, 0.f) & 0xffffu); }
__device__ __forceinline__ int crow(int r, int hi) { return (r & 3) + 8 * (r >> 2) + 4 * hi; }
__device__ __forceinline__ float half_sum(float v) {
    v += swz_xor<1>(v); v += swz_xor<2>(v); v += swz_xor<4>(v); v += swz_xor<8>(v); v += swz_xor<16>(v); return v;
}
__device__ __forceinline__ float half_max(float v) {
    v = fmaxf(v, swz_xor<1>(v)); v = fmaxf(v, swz_xor<2>(v)); v = fmaxf(v, swz_xor<4>(v)); v = fmaxf(v, swz_xor<8>(v)); v = fmaxf(v, swz_xor<16>(v)); return v;
}
__device__ __forceinline__ float swap_add(float v) { float lo, hi; halves(v, lo, hi); return lo + hi; }
__device__ __forceinline__ float wave_sum(float v) { return swap_add(half_sum(v)); }
__device__ __forceinline__ float wave_max(float v) { float lo, hi; halves(half_max(v), lo, hi); return fmaxf(lo, hi); }
typedef short v4i16_t __attribute__((ext_vector_type(4)));
__device__ __forceinline__ s16x4 vtr(const LAS unsigned char* p) { return __builtin_bit_cast(s16x4, __builtin_amdgcn_ds_read_tr16_b64_v4i16((LAS v4i16_t*)p)); }
__device__ __forceinline__ bf16x8 tr8(const LAS unsigned char* p, int second_off) {
    const s16x4 lo = vtr(p), hi = vtr(p + second_off);
    return (bf16x8){lo[0], lo[1], lo[2], lo[3], hi[0], hi[1], hi[2], hi[3]};
}
#define MFMA32(a, b, c) __builtin_amdgcn_mfma_f32_32x32x16_bf16(a, b, c, 0, 0, 0)

#define XB_TMO      128
#define XB_XCNT(j)  (256  + 64 * (j))
#define XB_XSUB(j)  (1280 + 64 * (j))
#define XB_XGEN(j)  (2304 + 64 * (j))
#define XB_TOP      3328
#define XB_TOPGEN   3392
#define XCD_BAR_WORDS 3456
#define XB_SPIN_CAP (1u << 18)

__device__ __forceinline__ unsigned xb_ld(unsigned* p)              { return __hip_atomic_load(p, __ATOMIC_RELAXED, __HIP_MEMORY_SCOPE_AGENT); }
__device__ __forceinline__ unsigned xb_add(unsigned* p, unsigned v) { return __hip_atomic_fetch_add(p, v, __ATOMIC_RELAXED, __HIP_MEMORY_SCOPE_AGENT); }
__device__ __forceinline__ unsigned xb_xcc_id() { return (unsigned)__builtin_amdgcn_s_getreg((3 << 11) | 20) & 0xFu; }
#define XB_SPIN(cond, bar) do { unsigned _sp = 0; while (cond) { __builtin_amdgcn_s_sleep(1); \
    if ((++_sp & 255u) == 0u) { if (xb_ld(&(bar)[XB_TMO])) break; if (_sp > XB_SPIN_CAP) { atomicAdd(&(bar)[XB_TMO], 1u); break; } } } } while (0)

struct XcdBarrier {
    unsigned* bar; unsigned x;
    volatile LAS unsigned* st;
};

__device__ __forceinline__ XcdBarrier xcd_barrier_post(unsigned* bar, volatile LAS unsigned* st) {
    XcdBarrier b; b.bar = bar; b.x = xb_xcc_id(); b.st = st;
    if (threadIdx.x == 0) (void)xb_add(&bar[XB_XCNT(b.x)], 1u);
    return b;
}
__device__ __forceinline__ void xcd_barrier_complete(unsigned* bar, unsigned x, unsigned& nloc, unsigned& nx) {
    const unsigned G = gridDim.x * gridDim.y * gridDim.z;
    unsigned sum, cnt, mine, sp = 0u;
    for (;;) {
        sum = 0u; cnt = 0u; mine = 0u;
#pragma unroll
        for (unsigned j = 0; j < 16; ++j) { const unsigned c = xb_ld(&bar[XB_XCNT(j)]); sum += c; cnt += (c > 0u) ? 1u : 0u; mine = (j == x) ? c : mine; }
        if (sum == G) break;
        __builtin_amdgcn_s_sleep(1);
        if ((++sp & 255u) == 0u) { if (xb_ld(&bar[XB_TMO])) break; if (sp > XB_SPIN_CAP) { atomicAdd(&bar[XB_TMO], 1u); break; } }
    }
    nloc = mine > 0u ? mine : 1u; nx = cnt > 0u ? cnt : 1u;
}

template <bool EXEC_ONLY = false>
__device__ __forceinline__ void xcd_barrier(const XcdBarrier& b, const bool is_thread0) {
    asm volatile("s_waitcnt vmcnt(0)" ::: "memory");
    __syncthreads();
    if (is_thread0) {
        unsigned* bar = b.bar;
        __builtin_amdgcn_s_waitcnt(0);
        unsigned nloc = b.st[0], nx = b.st[1];
        if (nloc == 0u) { xcd_barrier_complete(bar, b.x, nloc, nx); b.st[0] = nloc; b.st[1] = nx; }
        const unsigned old = xb_add(&bar[XB_XSUB(b.x)], 1u);
        const unsigned gen = old / nloc;
        if (old + 1u == (gen + 1u) * nloc) {
            if (!EXEC_ONLY) __builtin_amdgcn_fence(__ATOMIC_RELEASE, "agent");
            asm volatile("s_waitcnt vmcnt(0)" ::: "memory");
            const unsigned og = xb_add(&bar[XB_TOP], 1u);
            const unsigned tg = og / nx;
            if (og + 1u == (tg + 1u) * nx) xb_add(&bar[XB_TOPGEN], 1u);
            else XB_SPIN(xb_ld(&bar[XB_TOPGEN]) == tg, bar);
            if (!EXEC_ONLY) __builtin_amdgcn_fence(__ATOMIC_ACQUIRE, "agent");
            xb_add(&bar[XB_XGEN(b.x)], 1u);
            asm volatile("s_waitcnt vmcnt(0)" ::: "memory");
        } else {
            XB_SPIN(xb_ld(&bar[XB_XGEN(b.x)]) == gen, bar);
            if (!EXEC_ONLY) __builtin_amdgcn_fence(__ATOMIC_ACQUIRE, "agent");
            asm volatile("s_waitcnt vmcnt(0)" ::: "memory");
        }
    }
    __syncthreads();
}

struct Ctx { LAS unsigned char* lds; int tid, lane, wave, vcu, G; };

__device__ __forceinline__ void prologue_a(const Ctx& F, const float* c, const float* w_ada, float* modp) {
    const int gw = F.vcu * 8 + F.wave, NGW = F.G * 8;
    for (int it = gw; it < 96 * 16; it += NGW) {
        const int cg = it % 96, ks = it / 96; const int l = cg / 24, n0 = (cg % 24) * 256 + 4 * F.lane;
        const float* wp = w_ada + ((size_t)l * 1024 + ks * 64) * 6144 + n0;
        f32x4 a = {0.f, 0.f, 0.f, 0.f};
        const float cvl = c[ks * 64 + F.lane]; const float svl = cvl / (1.0f + __expf(-cvl));
#pragma unroll
        for (int kb = 0; kb < 2; ++kb) {
            f32x4 w[32];
#pragma unroll
            for (int k = 0; k < 32; ++k) w[k] = *(const f32x4*)(wp + (size_t)(32 * kb + k) * 6144);
#pragma unroll
            for (int k = 0; k < 32; ++k) a += __uint_as_float((unsigned)__builtin_amdgcn_readlane((int)__float_as_uint(svl), 32 * kb + k)) * w[k];
        }
        *(f32x4*)(modp + (size_t)ks * 24576 + cg * 256 + 4 * F.lane) = a;
    }
}
struct TrD { const float* W; bf16* WT; int ldw, K, k0, nsrc0, ndst0, kd, kind; float es; };
__device__ __forceinline__ void tr_load(const TrD& d, int lane, f32x4 (&r)[8]) {
#pragma unroll
    for (int i = 0; i < 8; ++i) { const int kk = 8 * i + (lane >> 3), n4 = 4 * (lane & 7); r[i] = *(const f32x4*)(d.W + (size_t)(d.k0 + kk) * d.ldw + d.nsrc0 + n4); }
}
__device__ __forceinline__ void tr_finish(const TrD& d, const f32x4 (&r)[8], LAS float* scr, int lane, const float* gs, const float* scf, const float* shf, u64* b1) {
#pragma unroll
    for (int i = 0; i < 8; ++i) { const int kk = 8 * i + (lane >> 3), n4 = 4 * (lane & 7); f32x4 wv_ = r[i];
        if (d.es > 0.f) { wv_.x = r8f(wv_.x, d.es); wv_.y = r8f(wv_.y, d.es); wv_.z = r8f(wv_.z, d.es); wv_.w = r8f(wv_.w, d.es); }
        LAS float* d_ = scr + kk * 33 + n4; d_[0] = wv_.x; d_[1] = wv_.y; d_[2] = wv_.z; d_[3] = wv_.w; }
    LDS_WAIT(); asm volatile("" ::: "memory");
    const int c = lane & 7; const int k0 = d.k0;
    if (d.kind == 1) {
#pragma unroll
        for (int j = 0; j < 4; ++j) { const int n = (lane >> 3) + 8 * j; const LAS float* s = scr + (8 * c) * 33 + n;
            int lo = __builtin_amdgcn_cvt_pk_fp8_f32(64.f * s[0 * 33], 64.f * s[1 * 33], 0, false); lo = __builtin_amdgcn_cvt_pk_fp8_f32(64.f * s[2 * 33], 64.f * s[3 * 33], lo, true);
            int hi = __builtin_amdgcn_cvt_pk_fp8_f32(64.f * s[4 * 33], 64.f * s[5 * 33], 0, false); hi = __builtin_amdgcn_cvt_pk_fp8_f32(64.f * s[6 * 33], 64.f * s[7 * 33], hi, true);
            v2u o; o.x = (unsigned)lo; o.y = (unsigned)hi;
            *(GAS v2u*)((unsigned char*)d.WT + (size_t)(d.ndst0 + n) * d.K * 2 + d.kd + k0 + 8 * c) = o; }
    } else if (d.kind == 2) {
        { const int n = lane & 31, kh = (lane >> 5) * 32; float p = 0.f;
#pragma unroll 8
          for (int kk = 0; kk < 32; ++kk) p += shf[k0 + kh + kk] * scr[(kh + kk) * 33 + n];
          atomicAdd(b1 + d.ndst0 + n, fx_enc(p, B1Q_)); }
        float sck[8];
#pragma unroll
        for (int e = 0; e < 8; ++e) sck[e] = gs[k0 + 8 * c + e] * (1.0f + scf[k0 + 8 * c + e]);
#pragma unroll
        for (int j = 0; j < 4; ++j) { const int n = (lane >> 3) + 8 * j; const LAS float* s = scr + (8 * c) * 33 + n;
            float sv_[8];
#pragma unroll
            for (int e = 0; e < 8; ++e) { sv_[e] = s[e * 33] * sck[e]; if (EMU8 & 2) sv_[e] = r8f(sv_[e], 64.f); }
            v4u o; o.x = pk2(sv_[0], sv_[1]); o.y = pk2(sv_[2], sv_[3]); o.z = pk2(sv_[4], sv_[5]); o.w = pk2(sv_[6], sv_[7]);
            *(GAS v4u*)(d.WT + (size_t)(d.ndst0 + n) * d.K + k0 + 8 * c) = o; }
    } else {
#pragma unroll
        for (int j = 0; j < 4; ++j) { const int n = (lane >> 3) + 8 * j; const LAS float* s = scr + (8 * c) * 33 + n;
            v4u o; o.x = pk2(s[0 * 33], s[1 * 33]); o.y = pk2(s[2 * 33], s[3 * 33]); o.z = pk2(s[4 * 33], s[5 * 33]); o.w = pk2(s[6 * 33], s[7 * 33]);
            *(GAS v4u*)(d.WT + (size_t)(d.ndst0 + n) * d.K + d.kd + k0 + 8 * c) = o; }
    }
    LDS_WAIT(); asm volatile("" ::: "memory");
}
__device__ __forceinline__ void prologue_b(const Ctx& F, const float* const* in, unsigned char* ws) {
    const int gt = F.vcu * 512 + F.tid;
    if (gt < 24576) { const float* mp = (const float*)(ws + WS_MODP); float s = in[3][gt];
#pragma unroll
        for (int k = 0; k < 16; ++k) s += mp[(size_t)k * 24576 + gt];
        ((float*)(ws + WS_MOD))[gt] = s; }
    if (gt >= 32768 && gt < 32768 + 1024) {
        const int i = gt - 32768, h = i >> 7, d = i & 127; const float* rel = in[13];
        int b; if (d < 16) b = d; else { const float nf = (float)d; int lg = 16 + (int)(logf(nf / 16.0f) / 2.0794415416798357f * 16.0f); b = lg < 31 ? lg : 31; }
        ((float*)(ws + WS_TAB))[i] = LOG2E_ * (rel[b * 8 + h] - rel[31 * 8 + h]); }
    if (gt >= 49152 && gt < 49152 + 4096) ((u64*)(ws + WS_B1))[gt - 49152] = zero64_opaque();
    if (gt >= 40960 && gt < 40960 + 4) {
        const int l = gt - 40960; const float* lq = in[11] + l * 256; float s01 = 0.f, s23 = 0.f;
        f32x4 a_[16], b_[16], c_[16], d_[16];
#pragma unroll
        for (int i = 0; i < 16; ++i) { a_[i] = *(const f32x4*)(lq + 4 * i); b_[i] = *(const f32x4*)(lq + 64 + 4 * i); c_[i] = *(const f32x4*)(lq + 128 + 4 * i); d_[i] = *(const f32x4*)(lq + 192 + 4 * i); }
#pragma unroll
        for (int i = 0; i < 16; ++i)
#pragma unroll
            for (int e = 0; e < 4; ++e) { s01 += a_[i][e] * b_[i][e]; s23 += c_[i][e] * d_[i][e]; }
        const float li = 0.8f - 0.6f * expf(-0.3f * (float)l);
        float* lt = (float*)(ws + WS_TAB + 4096) + l * 4; lt[0] = expf(s01) - expf(s23) + li; lt[1] = 1.0f - li; lt[2] = 0.f; lt[3] = 0.f; }
    { float* par = (float*)(ws + WS_PAR); const int NT = F.G * 512;
#define CP(off, src, n) for (int i = gt; i < DEPTH_ * (n); i += NT) { const int l_ = i / (n), j_ = i % (n); par[(size_t)l_ * PAR_L + (off) + j_] = (src)[i]; }
      CP(PR_NMG, in[4], 1024) CP(PR_NFG, in[5], 1024) CP(PR_QNG, in[9], 64) CP(PR_KNG, in[10], 64) CP(PR_SUBG, in[12], 128) CP(PR_MHG, in[16], 256)
      CP(PR_BIG, in[7], 4) CP(PR_BFG, in[8], 4) CP(PR_CONVB, in[15], 2048) CP(PR_CONVW, in[14], 8192)
#undef CP
      for (int i = gt; i < DEPTH_ * 8192; i += NT) { const int l_ = i >> 13, k_ = (i >> 3) & 1023, j_ = i & 7; par[(size_t)l_ * PAR_L + PR_GW + (i & 8191)] = in[6][((size_t)l_ * 1024 + k_) * NIN_SRC + GATE_COL + j_]; }
    }
}
__device__ __forceinline__ TrD wconv_item(int it, const float* const* in, unsigned char* wl, int l, int sel) {
    constexpr int I_IN = 16 * (NIN_ / 32), I_SQ = 16 * 32, I_F1 = 16 * 128;
    TrD d; d.W = nullptr; d.WT = nullptr; d.ldw = 0; d.K = 0; d.k0 = 0; d.nsrc0 = 0; d.ndst0 = 0; d.kd = 0; d.kind = -1; d.es = 0.f;
    int r = it;
    if (sel == 2 && (r < I_IN + 3 * I_SQ || r >= I_IN + 3 * I_SQ + I_F1)) return d;
    if (r < I_IN) { const int nb = r % (NIN_ / 32), kb = r / (NIN_ / 32); const int nd0 = nb * 32; int n = nd0;
        if (nd0 < 2048) { const int pn = nd0 >> 8, pc = nd0 & 255; n = pn * 256 + 64 * ((pc >> 5) & 3) + 32 * (pc >> 7); }
        d.W = in[6] + (size_t)l * 1024 * NIN_SRC; d.ldw = NIN_SRC; d.WT = (bf16*)(wl + W_IN); d.K = 1024; d.k0 = kb * 64; d.nsrc0 = n < GATE_COL ? n : n + 8; d.ndst0 = nd0;
        d.es = ((EMU8 & 1) || ((EMU8 & 8) && (nd0 < 2048 || nd0 >= 6144))) ? 64.f : 0.f; d.kind = (int)((PROJ8_TILES >> (nd0 >> 8)) & 1ull); return d; }
    r -= I_IN;
    if (r < 3 * I_SQ) { const int w = r / I_SQ, rr = r % I_SQ; const int nb = rr % 32, kb = rr / 32;
        d.W = in[17 + w] + (size_t)l * 1024 * 1024; d.ldw = 1024; d.k0 = kb * 64; d.nsrc0 = nb * 32; d.ndst0 = nb * 32; d.kind = 0;
        if (w < 2) { d.WT = (bf16*)(wl + W_A); d.K = 2048; d.kd = w * 1024; }
        else { d.WT = (bf16*)(wl + W_OUT); d.K = 1024; }
        return d; }
    r -= 3 * I_SQ;
    if (r < I_F1) { if (sel == 1) return d; const int nb = r % 128, kb = r / 128;
        d.W = in[20] + (size_t)l * 1024 * 4096; d.ldw = 4096; d.WT = (bf16*)(wl + W_F1); d.K = 1024; d.k0 = kb * 64; d.nsrc0 = nb * 32; d.ndst0 = nb * 32; d.kind = 2; return d; }
    r -= I_F1;
    { const int nb = r % 32, kb = r / 32;
      d.W = in[21] + (size_t)l * 4096 * 1024; d.ldw = 1024; d.WT = (bf16*)(wl + W_F2); d.K = 4096; d.k0 = kb * 64; d.nsrc0 = nb * 32; d.ndst0 = nb * 32; d.kind = 0; d.es = (EMU8 & 4) ? 128.f : 0.f; }
    return d;
}
__device__ __forceinline__ void wconv_layer(const Ctx& F, const float* const* in, unsigned char* wl, int l, int vcu0, const float* par_l, const float* mod_l, u64* b1, int sel = 0) {
    LAS float* scr = (LAS float*)(F.lds + F.wave * 16384);
    const int gw = (F.vcu - vcu0) * 8 + F.wave, NGW = (F.G - vcu0) * 8;
    constexpr int I_L = 16 * (NIN_ / 32) + 3 * 16 * 32 + 16 * 128 + 64 * 32;
    const float* gs = par_l ? par_l + PR_NFG : nullptr; const float* scf = mod_l ? mod_l + 4096 : nullptr; const float* shf = mod_l ? mod_l + 3072 : nullptr;
    int it = gw; TrD d; d.kind = -1; f32x4 r[8];
    if (it < I_L) { d = wconv_item(it, in, wl, l, sel); if (d.kind >= 0) tr_load(d, F.lane, r); }
    while (it < I_L) {
        const int itn = it + NGW; TrD dn; dn.kind = -1; f32x4 rn[8];
        if (itn < I_L) { dn = wconv_item(itn, in, wl, l, sel); if (dn.kind >= 0) tr_load(dn, F.lane, rn); }
        if (d.kind >= 0) tr_finish(d, r, scr, F.lane, gs, scf, shf, b1);
        d = dn; it = itn;
#pragma unroll
        for (int i = 0; i < 8; ++i) r[i] = rn[i];
    }
}
template <bool GATES>
__device__ __forceinline__ void norm_phase(const Ctx& F, const float* x, bf16* XN, const float* g, const float* sh, const float* sc,
                                           const float* win, const float* big, const float* bfg, float* IG, float* LF, u64* SS, u64* b1z, unsigned char* XN8 = nullptr) {
    const int gw = F.vcu * 8 + F.wave, NGW = F.G * 8; const int lane = F.lane;
    if (GATES) { const int gt = F.vcu * 512 + F.tid; if (gt < 4096) b1z[gt] = zero64_opaque(); }
    f32x4 gs[4], sv[4];
#pragma unroll
    for (int j = 0; j < 4; ++j) { const f32x4 gg = *(const f32x4*)(g + 4 * lane + 256 * j), s1 = *(const f32x4*)(sc + 4 * lane + 256 * j); gs[j] = gg * (1.0f + s1); sv[j] = *(const f32x4*)(sh + 4 * lane + 256 * j); }
    f32x4 wg[4][4][2];
    if (GATES) {
#pragma unroll
        for (int j = 0; j < 4; ++j)
#pragma unroll
            for (int i = 0; i < 4; ++i) { const float* wp = win + (size_t)(4 * lane + 256 * j + i) * 8; wg[j][i][0] = *(const f32x4*)wp; wg[j][i][1] = *(const f32x4*)(wp + 4); }
    }
    f32x4 vn[4];
    if (gw < S_) { const GAS f32x4* xr0 = (const GAS f32x4*)(x + (size_t)gw * 1024) + lane;
#pragma unroll
        for (int j = 0; j < 4; ++j) vn[j] = xr0[64 * j]; }
    for (int m = gw; m < S_; m += NGW) {
        f32x4 v[4]; float ss = 0.f;
#pragma unroll
        for (int j = 0; j < 4; ++j) v[j] = vn[j];
        if (m + NGW < S_) { const GAS f32x4* xr1 = (const GAS f32x4*)(x + (size_t)(m + NGW) * 1024) + lane;
#pragma unroll
            for (int j = 0; j < 4; ++j) vn[j] = xr1[64 * j]; }
#pragma unroll
        for (int j = 0; j < 4; ++j) ss += (v[j].x * v[j].x + v[j].y * v[j].y) + (v[j].z * v[j].z + v[j].w * v[j].w);
        const float r = 1.0f / sqrtf(wave_sum(ss) * (1.0f / 1024.0f) + EPS_);
        GAS v2u* o8 = (GAS v2u*)(XN + (size_t)m * 1024) + lane;
#pragma unroll
        for (int j = 0; j < 4; ++j) { v[j] = v[j] * r * gs[j] + sv[j]; f32x4 vq = v[j]; if (EMU8 & 1) { vq.x = r8f(vq.x, 1.f); vq.y = r8f(vq.y, 1.f); vq.z = r8f(vq.z, 1.f); vq.w = r8f(vq.w, 1.f); } v2u w; w.x = pk2(vq.x, vq.y); w.y = pk2(vq.z, vq.w); if (!(PROJ8 && GATES) || P8_HI > P8_LO) o8[64 * j] = w;
            if (PROJ8 && GATES) { int w8 = __builtin_amdgcn_cvt_pk_fp8_f32(v[j].x, v[j].y, 0, false); w8 = __builtin_amdgcn_cvt_pk_fp8_f32(v[j].z, v[j].w, w8, true);
                *(GAS int*)(XN8 + (size_t)m * 2048 + 4 * lane + 256 * j) = w8; } }
        if (GATES) {
            f32x4 d0 = {0.f, 0.f, 0.f, 0.f}, d1 = {0.f, 0.f, 0.f, 0.f};
#pragma unroll
            for (int j = 0; j < 4; ++j)
#pragma unroll
                for (int i = 0; i < 4; ++i) { d0 += v[j][i] * wg[j][i][0]; d1 += v[j][i] * wg[j][i][1]; }
#pragma unroll
            for (int q = 0; q < 4; ++q) { d0[q] = wave_sum(d0[q]); d1[q] = wave_sum(d1[q]); }
            if (lane == 0) SS[m] = zero64_opaque();
            if (lane < 4) {
                const float dq0 = lane == 0 ? d0[0] : (lane == 1 ? d0[1] : (lane == 2 ? d0[2] : d0[3])), dq1 = lane == 0 ? d1[0] : (lane == 1 ? d1[1] : (lane == 2 ? d1[2] : d1[3]));
                IG[(size_t)lane * S_ + m] = dq0 + big[lane]; const float z = dq1 + bfg[lane]; LF[(size_t)lane * S_ + m] = fminf(z, 0.f) - log1pf(__expf(-fabsf(z)));
            }
        }
    }
}

namespace att {
constexpr int QS_OFF = 73728;
constexpr int KSL8 = 8192, VSL = 8192, VRING = 4 * KSL8, BT_OFF = VRING + 4 * VSL, WS_OFF = BT_OFF + 2304;
__device__ __forceinline__ void glds(const void* g, LAS unsigned char* l) { __builtin_amdgcn_global_load_lds((const unsigned*)g, (LAS unsigned*)l, 16, 0, 0); }
#define SB0() __builtin_amdgcn_sched_barrier(0)
typedef float f32x2_t __attribute__((ext_vector_type(2))); typedef __bf16 bf16x2_t __attribute__((ext_vector_type(2)));
__device__ __forceinline__ unsigned cvtpk_s(float lo, float hi) { f32x2_t v = {lo, hi}; bf16x2_t b = __builtin_convertvector(v, bf16x2_t); return __builtin_bit_cast(unsigned, b); }
#define EXP2F(x) __builtin_amdgcn_exp2f(x)
#define PIN(x) asm volatile("" : "+v"(x))
template <bool NEAR>
__device__ __forceinline__ void ex4(const f32x16& P, int b, unsigned& w0, unsigned& w1, float& sacc, const LAS float* tb, int o) {
    float x0 = P[b], x1 = P[b + 1], x2 = P[b + 2], x3 = P[b + 3];
    if (NEAR) { x0 += tb[o]; x1 += tb[o + 1]; x2 += tb[o + 2]; x3 += tb[o + 3]; }
    x0 = EXP2F(x0); x1 = EXP2F(x1); x2 = EXP2F(x2); x3 = EXP2F(x3);
    w0 = cvtpk_s(x0, x1); w1 = cvtpk_s(x2, x3); sacc += (x0 + x1) + (x2 + x3);
    PIN(w0); PIN(w1); PIN(sacc);
}
#define DSR128(dst, addr, off) asm volatile("ds_read_b128 %0, %1 offset:" #off : "=v"(dst) : "v"(addr))
#define K8ADDR(kslot) ((kslot) + lofsK)
#define V8ADDR(vslot) ((vslot) + lofsV)
typedef int i32x8 __attribute__((ext_vector_type(8)));
typedef int i32x4 __attribute__((ext_vector_type(4)));
#define LD8(p, o0, o1) __builtin_shufflevector(*(const LAS i32x4*)((p) + (o0)), *(const LAS i32x4*)((p) + (o1)), 0, 1, 2, 3, 4, 5, 6, 7)
#define I8(a, c) ((i32x8){(int)(a).x, (int)(a).y, (int)(a).z, (int)(a).w, (int)(c).x, (int)(c).y, (int)(c).z, (int)(c).w})
#define P8(p, o) ((i32x8){p[o], p[o + 1], p[o + 2], p[o + 3], p[o + 4], p[o + 5], p[o + 6], p[o + 7]})
#define SC_PACK 0x7c7f
#define MFMA8QK(a, b) __builtin_amdgcn_mfma_scale_f32_32x32x64_f8f6f4(a, b, f32x16{}, 0, 0, 0, SC_PACK, 1, SC_PACK)
#define MFMA8PV(p, v, c) __builtin_amdgcn_mfma_scale_f32_32x32x64_f8f6f4(p, v, c, 1, 0, 0, SC_PACK, 0, SC_PACK)
template <bool NEAR>
__device__ __forceinline__ int ex4(const f32x16& P, int b, const LAS float* tb, int o) {
    float x0 = P[b], x1 = P[b + 1], x2 = P[b + 2], x3 = P[b + 3];
    if (NEAR) { x0 += tb[o]; x1 += tb[o + 1]; x2 += tb[o + 2]; x3 += tb[o + 3]; }
    x0 = EXP2F(x0); x1 = EXP2F(x1); x2 = EXP2F(x2); x3 = EXP2F(x3);
    int w; asm volatile("" : "=v"(w));
    w = __builtin_amdgcn_cvt_pk_bf8_f32(x0, x1, w, false);
    w = __builtin_amdgcn_cvt_pk_bf8_f32(x2, x3, w, true);
    return w;
}
#define MFMA8SUM(acc, p) asm volatile("v_mfma_scale_f32_16x16x128_f8f6f4 %0, %1, %2, %0, %3, %3 op_sel_hi:[0,0,0] blgp:1" : "+v"(acc) : "v"(aones), "v"(p), "v"(sc1))
template <bool NEAR>
__device__ __forceinline__ void tile_step(f32x16 (&o1)[4], f32x16 (&o2)[4], f32x4& s1, f32x4& s2, const LAS unsigned char* kslot, const LAS unsigned char* knext, const LAS unsigned char* vprev, const LAS unsigned char* qs,
                                          const LAS float* BT, int dist0, int lofsK, int lofsV, const i32x8 (&pp)[2], i32x8 (&pn)[2], i32x8& kf, i32x8& qf, const i32x8& aones, const int sc1, const i32x8& qg) {
    const LAS unsigned char* kb = K8ADDR(kslot); const LAS unsigned char* vp = V8ADDR(vprev); int dkn = (int)(knext - kslot); asm volatile("" : "+s"(dkn));
    const LAS float* tb = BT + (448 - dist0 + ((lofsK >> 9) & 4));
    i32x8 vf; f32x16 R0, R1;
    R0 = MFMA8QK(kf, qf);
    kf = LD8(kb, 512, 1536); vf = LD8(vp, 0, 2048);
    SB0();
    R1 = MFMA8QK(kf, qf);
    kf = LD8(kb, 4096, 5120);
    SB0();
    pn[0][0] = ex4<NEAR>(R0, 0, tb, 0);
    SB0();
    o1[0] = MFMA8PV(pp[0], vf, o1[0]);
    pn[0][1] = ex4<NEAR>(R0, 4, tb, 8);
    pn[0][2] = ex4<NEAR>(R0, 8, tb, 16);
    SB0();
    o2[0] = MFMA8PV(pp[1], vf, o2[0]);
    vf = LD8(vp, 512, 2560);
    pn[0][3] = ex4<NEAR>(R0, 12, tb, 24);
    SB0();
    R0 = MFMA8QK(kf, qg);
    kf = LD8(kb, 4608, 5632);
    pn[0][4] = ex4<NEAR>(R1, 0, tb, 32);
    SB0();
    o1[1] = MFMA8PV(pp[0], vf, o1[1]);
    MFMA8SUM(s1, pp[0]);
    pn[0][5] = ex4<NEAR>(R1, 4, tb, 40);
    pn[0][6] = ex4<NEAR>(R1, 8, tb, 48);
    SB0();
    o2[1] = MFMA8PV(pp[1], vf, o2[1]);
    vf = LD8(vp, 1024, 3072);
    pn[0][7] = ex4<NEAR>(R1, 12, tb, 56);
    SB0();
    R1 = MFMA8QK(kf, qg);
    { const LAS unsigned char* kn = kb + dkn; kf = LD8(kn, 0, 1024); }
    pn[1][0] = ex4<NEAR>(R0, 0, tb, 0);
    SB0();
    o1[2] = MFMA8PV(pp[0], vf, o1[2]);
    MFMA8SUM(s2, pp[1]);
    pn[1][1] = ex4<NEAR>(R0, 4, tb, 8);
    pn[1][2] = ex4<NEAR>(R0, 8, tb, 16);
    SB0();
    o2[2] = MFMA8PV(pp[1], vf, o2[2]);
    vf = LD8(vp, 1536, 3584);
    pn[1][3] = ex4<NEAR>(R0, 12, tb, 24);
    SB0();
    o1[3] = MFMA8PV(pp[0], vf, o1[3]);
    pn[1][4] = ex4<NEAR>(R1, 0, tb, 32);
    pn[1][5] = ex4<NEAR>(R1, 4, tb, 40);
    SB0();
    o2[3] = MFMA8PV(pp[1], vf, o2[3]);
    pn[1][6] = ex4<NEAR>(R1, 8, tb, 48);
    pn[1][7] = ex4<NEAR>(R1, 12, tb, 56);
    SB0();
}
__device__ __forceinline__ void pv_flush(f32x16 (&o1)[4], f32x16 (&o2)[4], const LAS unsigned char* vprev, int lofsK, int lofsV, const i32x8 (&pp)[2], f32x4& s1, f32x4& s2, const i32x8& aones, const int sc1) {
    const LAS unsigned char* vp = V8ADDR(vprev);
    i32x8 vf;
    vf = LD8(vp, 0, 2048);
    o1[0] = MFMA8PV(pp[0], vf, o1[0]);
    o2[0] = MFMA8PV(pp[1], vf, o2[0]);
    vf = LD8(vp, 512, 2560);
    o1[1] = MFMA8PV(pp[0], vf, o1[1]);
    o2[1] = MFMA8PV(pp[1], vf, o2[1]);
    vf = LD8(vp, 1024, 3072);
    o1[2] = MFMA8PV(pp[0], vf, o1[2]);
    o2[2] = MFMA8PV(pp[1], vf, o2[2]);
    vf = LD8(vp, 1536, 3584);
    o1[3] = MFMA8PV(pp[0], vf, o1[3]);
    o2[3] = MFMA8PV(pp[1], vf, o2[3]);
    MFMA8SUM(s1, pp[0]); MFMA8SUM(s2, pp[1]);
}
__device__ __forceinline__ void vtrans_phase(const Ctx& F, const bf16* Vb, unsigned char* V8T) {
    const int lane = F.lane; LAS unsigned char* blk = F.lds + F.wave * 8192;
    for (int it = F.vcu * 8 + F.wave; it < 8 * 256; it += F.G * 8) {
        const int h = it >> 8, T = it & 255;
#pragma unroll 4
        for (int i = 0; i < 16; ++i) { const int p = lane + 64 * i, key = p >> 4, ch = p & 15;
            const v4u w = *(const v4u*)(Vb + (size_t)(T * 64 + key) * 1024 + h * 128 + ch * 8);
            int lo = 0, hi4 = 0;
            lo = __builtin_amdgcn_cvt_pk_fp8_f32(pg8::bflo(w.x), pg8::bfhi(w.x), lo, false); lo = __builtin_amdgcn_cvt_pk_fp8_f32(pg8::bflo(w.y), pg8::bfhi(w.y), lo, true);
            hi4 = __builtin_amdgcn_cvt_pk_fp8_f32(pg8::bflo(w.z), pg8::bfhi(w.z), hi4, false); hi4 = __builtin_amdgcn_cvt_pk_fp8_f32(pg8::bflo(w.w), pg8::bfhi(w.w), hi4, true);
            const int pos = ((key >> 2) & 1) * 32 + ((key >> 5) & 1) * 16 + ((key >> 3) & 3) * 4 + (key & 3);
            LAS unsigned char* d = blk + (ch * 8) * 64 + pos;
            d[0 * 64] = (unsigned char)(lo); d[1 * 64] = (unsigned char)(lo >> 8); d[2 * 64] = (unsigned char)(lo >> 16); d[3 * 64] = (unsigned char)(lo >> 24);
            d[4 * 64] = (unsigned char)(hi4); d[5 * 64] = (unsigned char)(hi4 >> 8); d[6 * 64] = (unsigned char)(hi4 >> 16); d[7 * 64] = (unsigned char)(hi4 >> 24); }
        LDS_WAIT(); asm volatile("" ::: "memory");
        unsigned char* out = V8T + (size_t)it * 8192;
#pragma unroll
        for (int i = 0; i < 8; ++i) { const int p = lane + 64 * i; *(v4u*)(out + p * 16) = *(const LAS v4u*)(blk + p * 16); }
        LDS_WAIT(); asm volatile("" ::: "memory");
    }
}
__device__ __forceinline__ void epilogue(const Ctx& F, const f32x16 (&o1)[4], const f32x16 (&o2)[4], float l1, float l2, int h, int qw, bf16* Y, float lam, float oml, const float* subg) {
    const int lane = lane_id_opaque(), wid = F.wave, r32 = lane & 31, hi = lane >> 5;
    LAS float* wsf = (LAS float*)(F.lds + WS_OFF) + wid * 64;

    if (hi == 0) { wsf[r32] = 1.0f / l1; wsf[32 + r32] = lam / l2; }
    LDS_WAIT(); asm volatile("" ::: "memory");
    float gsub[4];
#pragma unroll
    for (int db = 0; db < 4; ++db) gsub[db] = subg[32 * db + r32] * oml;
#pragma unroll
    for (int r = 0; r < 16; ++r) {
        const int row = crow(r, hi); const float a = wsf[row], b = wsf[32 + row];
        float y[4]; float ss = 0.f;
#pragma unroll
        for (int db = 0; db < 4; ++db) { y[db] = o1[db][r] * a - o2[db][r] * b; ss += y[db] * y[db]; }
        ss = half_sum(ss);
        const float rs = __builtin_amdgcn_rsqf(ss * (1.0f / 128.0f) + EPS_);
        LAS unsigned char* sp = (r < 8 ? F.lds + wid * 4096 : F.lds + QS_OFF + wid * 4096) + (row & 15) * 256 + r32 * 2;
#pragma unroll
        for (int db = 0; db < 4; ++db) *(LAS bf16*)(sp + 64 * db) = f2bf(DBG_ATT_SCALE * y[db] * rs * gsub[db]);
    }
    LDS_WAIT(); asm volatile("" ::: "memory");
#pragma unroll
    for (int half = 0; half < 2; ++half) { const LAS unsigned char* stg = half ? F.lds + QS_OFF + wid * 4096 : F.lds + wid * 4096;
#pragma unroll
        for (int i = 0; i < 4; ++i) { const int p = lane + 64 * i, rowh = p >> 4, ch = p & 15;
            *(v4u*)(Y + (size_t)(qw + 16 * half + rowh) * 2048 + h * 128 + 8 * ch) = *(const LAS v4u*)(stg + rowh * 256 + ch * 16); } }
    asm volatile("s_waitcnt lgkmcnt(0)" ::: "memory"); __builtin_amdgcn_s_barrier(); asm volatile("" ::: "memory");
}
__device__ __forceinline__ void attn_unit(const Ctx& F, int h, int qb, const bf16* Qb, const unsigned char* K8, const unsigned char* V8T, bf16* Y, const float* bt2, float lam, float oml, const float* subg) {
    LAS unsigned char* lds = F.lds; const int lane = lane_id_opaque(), wid = F.wave, tid = wid * 64 + lane, r32 = lane & 31, hi = lane >> 5;
    const int q0 = qb * 256, NT = (q0 + 256) / 64, qw = q0 + 32 * wid;
    LAS float* BT = (LAS float*)(lds + BT_OFF);
    float btv = -INFINITY; { const int d = 448 - tid; if (d >= 0) btv = d < 128 ? bt2[d] : 0.f; }
    v2u qraw[2][4];
    { const unsigned char* Qrow = (const unsigned char*)Qb + (size_t)(qw + r32) * 1024 + h * 128;
#pragma unroll
      for (int cp = 0; cp < 2; ++cp)
#pragma unroll
          for (int d0 = 0; d0 < 4; ++d0) qraw[cp][d0] = *(const v2u*)(Qrow + cp * 64 + d0 * 16 + hi * 8); }
    const unsigned klo = (unsigned)(lane * 1024 + h * 128 + wid * 16);
    const unsigned vlo = (unsigned)((64 * (wid >> 2) + lane) * 64 + (wid & 3) * 16);
    LAS unsigned char* kd = lds + wid * 1024; LAS unsigned char* vd = lds + VRING + (wid & 3) * 2048 + (wid >> 2) * 1024;
#define ATT_DMA(t, b_) do { const char* kp_ = (const char*)K8 + (size_t)(t) * (64 * 1024); const char* vp_ = (const char*)V8T + ((size_t)h * 256 + (t)) * 8192; asm volatile("" : "+s"(kp_), "+s"(vp_)); \
        glds(kp_ + klo, kd + (b_) * KSL8); glds(vp_ + vlo, vd + (b_) * VSL); } while (0)
#define ATT_SYNC(n_) do { asm volatile("s_waitcnt vmcnt(" #n_ ") lgkmcnt(0)" ::: "memory"); __builtin_amdgcn_s_barrier(); asm volatile("" ::: "memory"); } while (0)
    f32x16 o1[4], o2[4];
#pragma unroll
    for (int i = 0; i < 4; ++i) { o1[i] = f32x16{}; o2[i] = f32x16{}; }
    f32x4 s1 = {0.f, 0.f, 0.f, 0.f}, s2 = {0.f, 0.f, 0.f, 0.f};
    int one8 = (lane == 0 || lane == 32 || lane == 17 || lane == 49) ? 0x38383838 : 0; asm volatile("" : "+v"(one8));
    const i32x8 aones = {one8, one8, one8, one8, one8, one8, one8, one8};
    const int sc1 = SC_PACK;
    asm volatile("s_waitcnt lgkmcnt(0)" ::: "memory"); __builtin_amdgcn_s_barrier(); asm volatile("" ::: "memory");
    { unsigned z_ = 0u; asm volatile("" : "+v"(z_)); *(LAS v4u*)(lds + VRING + 3 * VSL + tid * 16) = v4u{z_, z_, z_, z_}; }
    ATT_DMA(0, 0); ATT_DMA(1, 1);
    BT[tid] = btv; if (tid < 32) BT[512 + tid] = -INFINITY;
    i32x8 q8[2];
    {
#pragma unroll
      for (int cp = 0; cp < 2; ++cp)
#pragma unroll
          for (int d0 = 0; d0 < 4; ++d0) { q8[cp][2 * d0] = (int)qraw[cp][d0].x; q8[cp][2 * d0 + 1] = (int)qraw[cp][d0].y; } }
    LAS unsigned char* qs = lds + QS_OFF + wid * 4096 + lane * 16;
#pragma unroll
    for (int cp = 0; cp < 2; ++cp) { *(LAS i32x4*)(qs + cp * 2048) = __builtin_shufflevector(q8[cp], q8[cp], 0, 1, 2, 3); *(LAS i32x4*)(qs + cp * 2048 + 1024) = __builtin_shufflevector(q8[cp], q8[cp], 4, 5, 6, 7); }
    ATT_SYNC(0);
    int lofsK = hi * 2048 + r32 * 16, lofsV = hi * 4096 + r32 * 16; asm volatile("" : "+v"(lofsK), "+v"(lofsV));
    i32x8 pA[2], pB[2]; i32x8 kf, qf = q8[0];
    pA[0] = i32x8{}; pA[1] = i32x8{};
    { const LAS unsigned char* kb0 = K8ADDR(lds); kf = LD8(kb0, 0, 1024); }
#define KS_(t_) (lds + ((t_) & 3) * KSL8)
#define VS_(t_) (lds + VRING + ((t_) & 3) * VSL)
    const int tA = q0 >= 191 ? (q0 - 191) / 64 + 1 : 0;
    for (int t = 0; t < tA; t += 2) {
        ATT_DMA(t + 2, (t + 2) & 3);
        tile_step<false>(o1, o2, s1, s2, KS_(t), KS_(t + 1), VS_(t + 3), qs, BT, 0, lofsK, lofsV, pA, pB, kf, qf, aones, sc1, q8[1]);
        ATT_SYNC(0);
        ATT_DMA(t + 3, (t + 3) & 3);
        tile_step<false>(o1, o2, s1, s2, KS_(t + 1), KS_(t + 2), VS_(t), qs, BT, 0, lofsK, lofsV, pB, pA, kf, qf, aones, sc1, q8[1]);
        ATT_SYNC(0);
    }
    int qwr = qw + (lane_id_opaque() & 31); asm volatile("" : "+v"(qwr));
    for (int t = tA; t < NT; ++t) {
        if (t + 2 < NT) ATT_DMA(t + 2, (t + 2) & 3);
        if (64 * t <= qw + 31) {
            tile_step<true>(o1, o2, s1, s2, KS_(t), KS_(t + 1), VS_(t + 3), qs, BT, qwr - 64 * t, lofsK, lofsV, pA, pB, kf, qf, aones, sc1, q8[1]);
            pA[0] = pB[0]; pA[1] = pB[1];
        }
        ATT_SYNC(0);
    }
    { const int tl = min(NT - 1, (qw + 31) >> 6); pv_flush(o1, o2, VS_(tl), lofsK, lofsV, pA, s1, s2, aones, sc1); }
#undef KS_
#undef VS_
#undef ATT_DMA
#undef ATT_SYNC
    asm volatile("s_nop 15\n\ts_nop 15\n\ts_nop 15\n\ts_nop 15\n\ts_nop 15\n\ts_nop 15" : "+v"(s1), "+v"(s2));
    const int r32e = lane_id_opaque() & 31;
    float l10 = bperm(s1[0], r32e & 15), l11 = bperm(s1[1], r32e & 15), l20 = bperm(s2[0], r32e & 15), l21 = bperm(s2[1], r32e & 15);
    asm volatile("" : "+v"(l10), "+v"(l11), "+v"(l20), "+v"(l21));
    const float l1s = (r32e & 16) ? l11 : l10, l2s = (r32e & 16) ? l21 : l20;
    epilogue(F, o1, o2, l1s, l2s, h, qw, Y, lam, oml, subg);
}
}

namespace mls {
constexpr int L = 128, NC = S_ / L;
constexpr int ST1 = 520;
constexpr int VT_OFF = 0, KT_OFF = 128 * ST1, TB_OFF = 2 * 128 * ST1;
__device__ __forceinline__ void step1_unit(const Ctx& F, int l, int h, int c, const float* LF, const float* IG, float* BC, float* AA, float* BL, float* ML,
                                           const bf16* MQKR, const bf16* MV, bf16* MQ, bf16* MK, const float* conv_w, const float* conv_b, bf16* UB, float* NU) {
    LAS unsigned char* lds = F.lds; const int lane = lane_id_opaque(), wid = F.wave, tid = wid * 64 + lane, hi = lane >> 5;
    const int t0 = c * L; LAS float* wkt = (LAS float*)(lds + TB_OFF);
    const size_t gi = (size_t)h * S_ + t0 + 2 * lane;
    float lf0 = 0.f, lf1 = 0.f, ig0 = 0.f, ig1 = 0.f;
    if (wid == 0) { lf0 = LF[gi]; lf1 = LF[gi + 1]; ig0 = IG[gi]; ig1 = IG[gi + 1]; }
    v4u vt[8];
#pragma unroll
    for (int i = 0; i < 8; ++i) { const int idx = tid + 512 * i, row = idx >> 5, pc = idx & 31; vt[i] = *(const v4u*)(MV + (size_t)(t0 + row) * 1024 + h * 256 + pc * 8); }
    v4u rawq[11], rawk[11];
    { const int dg = tid & 31, rg = tid >> 5;
#pragma unroll
      for (int rr = 0; rr < 11; ++rr) { const int t = t0 + 8 * rg + rr - 3; rawq[rr] = (v4u){0u, 0u, 0u, 0u}; rawk[rr] = (v4u){0u, 0u, 0u, 0u};
          if (t >= 0) { rawq[rr] = *(const v4u*)(MQKR + (size_t)t * 2048 + h * 256 + 8 * dg); rawk[rr] = *(const v4u*)(MQKR + (size_t)t * 2048 + 1024 + h * 256 + 8 * dg); } } }
    if (wid == 0) {
        float s = lf0 + lf1;
#pragma unroll
        for (int o = 1; o < 64; o <<= 1) { const float y = bperm(s, lane - o); if (lane >= o) s += y; }
        const float bc1 = s, bc0 = s - lf1, blast = bperm(s, 63);
        const float a0 = ig0 - bc0, a1 = ig1 - bc1, g0 = blast + a0, g1 = blast + a1;
        const float mloc = wave_max(fmaxf(g0, g1));
        wkt[2 * lane] = __expf(g0 - mloc); wkt[2 * lane + 1] = __expf(g1 - mloc);
        BC[gi] = bc0; BC[gi + 1] = bc1; AA[gi] = a0; AA[gi + 1] = a1;
        if (lane == 0) { BL[h * NC + c] = blast; ML[h * NC + c] = mloc; }
    }
    f32x4 cwa[2][4][2], cba[2][2];
#define CONV_LD(W_) do { const int cb_ = (W_) * 1024 + h * 256 + 8 * (tid & 31); _Pragma("unroll") for (int j = 0; j < 4; ++j) { cwa[W_][j][0] = *(const f32x4*)(conv_w + (size_t)j * 2048 + cb_); cwa[W_][j][1] = *(const f32x4*)(conv_w + (size_t)j * 2048 + cb_ + 4); } \
        cba[W_][0] = *(const f32x4*)(conv_b + cb_); cba[W_][1] = *(const f32x4*)(conv_b + cb_ + 4); } while (0)
    CONV_LD(0);
#pragma unroll
    for (int i = 0; i < 8; ++i) { const int idx = tid + 512 * i, row = idx >> 5, pc = idx & 31;
        LAS v2u* d = (LAS v2u*)(lds + VT_OFF + row * ST1 + pc * 16); d[0] = (v2u){vt[i].x, vt[i].y}; d[1] = (v2u){vt[i].z, vt[i].w}; }
    CONV_LD(1);
#undef CONV_LD
    __syncthreads();
    { const int dg = tid & 31, rg = tid >> 5;
#pragma unroll
      for (int which = 0; which < 2; ++which) {
        float cw[4][8], cbias[8];
#pragma unroll
        for (int j = 0; j < 4; ++j) { const f32x4 w0 = cwa[which][j][0], w1 = cwa[which][j][1];
#pragma unroll
            for (int e = 0; e < 4; ++e) { cw[j][e] = w0[e]; cw[j][4 + e] = w1[e]; } }
        { const f32x4 b0 = cba[which][0], b1 = cba[which][1];
#pragma unroll
          for (int e = 0; e < 4; ++e) { cbias[e] = b0[e]; cbias[4 + e] = b1[e]; } }
        v4u raw[11];
#pragma unroll
        for (int rr = 0; rr < 11; ++rr) raw[rr] = which ? rawk[rr] : rawq[rr];
#pragma unroll
        for (int r = 0; r < 8; ++r) {
            float y[8];
#pragma unroll
            for (int e = 0; e < 8; ++e) y[e] = cbias[e];
#pragma unroll
            for (int j = 0; j < 4; ++j) { const v4u w = raw[r + j];
                y[0] += cw[j][0] * pg8::bflo(w.x); y[1] += cw[j][1] * pg8::bfhi(w.x); y[2] += cw[j][2] * pg8::bflo(w.y); y[3] += cw[j][3] * pg8::bfhi(w.y);
                y[4] += cw[j][4] * pg8::bflo(w.z); y[5] += cw[j][5] * pg8::bfhi(w.z); y[6] += cw[j][6] * pg8::bflo(w.w); y[7] += cw[j][7] * pg8::bfhi(w.w); }
            const float scl = which ? 0.0625f : 1.0f;
#pragma unroll
            for (int e = 0; e < 8; ++e) y[e] = y[e] * pg8::sigm(y[e]) * scl;
            const int row = 8 * rg + r;
            const v4u o = (v4u){pk2(y[0], y[1]), pk2(y[2], y[3]), pk2(y[4], y[5]), pk2(y[6], y[7])};
            *(v4u*)((which ? MK : MQ) + (size_t)(t0 + row) * 1024 + h * 256 + 8 * dg) = o;
            if (which) { const float wk = wkt[row];
                LAS v2u* d = (LAS v2u*)(lds + KT_OFF + row * ST1 + dg * 16);
                d[0] = (v2u){pk2(y[0] * wk, y[1] * wk), pk2(y[2] * wk, y[3] * wk)}; d[1] = (v2u){pk2(y[4] * wk, y[5] * wk), pk2(y[6] * wk, y[7] * wk)}; }
        }
      }
    }
    __syncthreads();
    if (tid < 256) { float s = 0.f; const LAS bf16* kp = (const LAS bf16*)(lds + KT_OFF) + tid;
#pragma unroll 8
        for (int r = 0; r < L; ++r) s += bf2f(kp[r * (ST1 / 2)]);
        NU[((size_t)h * NC + c) * 256 + tid] = s; }
    { const int eb = wid >> 1, dh = wid & 1;
      f32x16 acc[2][4];
#pragma unroll
      for (int mi = 0; mi < 2; ++mi)
#pragma unroll
          for (int ni = 0; ni < 4; ++ni) acc[mi][ni] = f32x16{};
      const int trow = 8 * hi + ((lane & 15) >> 2), tcol = 16 * ((lane >> 4) & 1) + 4 * (lane & 3);
      const LAS unsigned char* va = lds + VT_OFF + trow * ST1 + (64 * eb + tcol) * 2;
      const LAS unsigned char* ka = lds + KT_OFF + trow * ST1 + (128 * dh + tcol) * 2;
#pragma unroll 1
      for (int ks = 0; ks < 8; ++ks) {
          bf16x8 a[2], b[4];
#pragma unroll
          for (int mi = 0; mi < 2; ++mi) a[mi] = tr8(va + ks * 16 * ST1 + mi * 64, 4 * ST1);
#pragma unroll
          for (int ni = 0; ni < 4; ++ni) b[ni] = tr8(ka + ks * 16 * ST1 + ni * 64, 4 * ST1);
#pragma unroll
          for (int mi = 0; mi < 2; ++mi)
#pragma unroll
              for (int ni = 0; ni < 4; ++ni) acc[mi][ni] = MFMA32(a[mi], b[ni], acc[mi][ni]);
      }
      __syncthreads();
      LAS unsigned char* stg = lds + wid * 17408;
#pragma unroll
      for (int mi = 0; mi < 2; ++mi)
#pragma unroll
          for (int ni = 0; ni < 4; ++ni)
#pragma unroll
              for (int r = 0; r < 16; ++r) *(LAS bf16*)(stg + (32 * mi + crow(r, hi)) * 272 + (32 * ni + (lane & 31)) * 2) = f2bf(acc[mi][ni][r]);
      LDS_WAIT(); asm volatile("" ::: "memory");
      bf16* up = UB + ((size_t)h * NC + c) * 65536 + (size_t)(64 * eb) * 256 + 128 * dh;
#pragma unroll
      for (int i = 0; i < 16; ++i) { const int p = lane + 64 * i, row = p >> 4, ch = p & 15; *(v4u*)(up + (size_t)row * 256 + 8 * ch) = *(const LAS v4u*)(stg + row * 272 + ch * 16); }
    }
    __syncthreads();
}
__device__ __forceinline__ double bperm64(double v, int src_lane) { const unsigned long long b = __builtin_bit_cast(unsigned long long, v);
    const unsigned lo = (unsigned)__builtin_amdgcn_ds_bpermute(src_lane << 2, (int)(unsigned)b), hi = (unsigned)__builtin_amdgcn_ds_bpermute(src_lane << 2, (int)(unsigned)(b >> 32));
    return __builtin_bit_cast(double, ((unsigned long long)hi << 32) | lo); }
struct GateTab { float fa0, fb0, mp0, fa1, fb1, mp1; };
__device__ __forceinline__ GateTab gate_tables(const float* BL, const float* ML, int h, int lane) {
    const float blf0 = BL[h * NC + 2 * lane], blf1 = BL[h * NC + 2 * lane + 1], mlf0 = ML[h * NC + 2 * lane], mlf1 = ML[h * NC + 2 * lane + 1];
    const double bl0 = blf0, bl1 = blf1, ml0 = mlf0, ml1 = mlf1;
    double ps = bl0 + bl1;
#pragma unroll
    for (int o = 1; o < 64; o <<= 1) { const double y = bperm64(ps, lane - o); if (lane >= o) ps += y; }
    const double S1 = ps, S0 = ps - bl1, t0 = ml0 - S0, t1 = ml1 - S1;
    double pmx = fmax(t0, t1);
#pragma unroll
    for (int o = 1; o < 64; o <<= 1) { const double y = bperm64(pmx, lane - o); if (lane >= o) pmx = fmax(pmx, y); }
    double prev = bperm64(pmx, lane - 1); if (lane == 0) prev = -1.0e300;
    const double PM0 = fmax(prev, t0), m0 = S0 + fmax(0.0, PM0), m1 = S1 + fmax(0.0, pmx);
    double mprev0 = bperm64(m1, lane - 1); if (lane == 0) mprev0 = 0.0;
    GateTab g; g.fa0 = __expf((float)(bl0 + mprev0 - m0)); g.fb0 = __expf((float)(ml0 - m0)); g.mp0 = (float)mprev0;
    g.fa1 = __expf((float)(bl1 + m0 - m1)); g.fb1 = __expf((float)(ml1 - m1)); g.mp1 = (float)m0;
    return g;
}
__device__ __forceinline__ float rdl(float v, int l) { return __uint_as_float((unsigned)__builtin_amdgcn_readlane((int)__float_as_uint(v), l)); }
__device__ __forceinline__ void scan_phase(const Ctx& F, const bf16* UB, bf16* CST, const float* BL, const float* ML, float* MP, const float* NU, float* NST) {
    const int gt = F.vcu * 512 + F.tid, lane = F.tid & 63;
    if (gt < 65536) {
        const int h = gt >> 14, e = (gt >> 6) & 255, d0 = 4 * (gt & 63);
        const size_t base = (size_t)h * NC * 65536 + (size_t)e * 256 + d0;
        v2u ua[16], ub[16];
#pragma unroll
        for (int i = 0; i < 16; ++i) ua[i] = *(const v2u*)(UB + base + (size_t)i * 65536);
        const GateTab g = gate_tables(BL, ML, h, lane);
        if ((gt & 16383) < 64) { MP[h * NC + 2 * lane] = g.mp0; MP[h * NC + 2 * lane + 1] = g.mp1; }
        float C0 = 0.f, C1 = 0.f, C2 = 0.f, C3 = 0.f;
#define SCAN_STEPS(U, CB) _Pragma("unroll") for (int i = 0; i < 16; ++i) { \
                *(v2u*)(CST + base + (size_t)((CB) + i) * 65536) = (v2u){pk2(C0, C1), pk2(C2, C3)}; \
                const float fa = rdl((i & 1) ? g.fa1 : g.fa0, ((CB) >> 1) + (i >> 1)), fb = rdl((i & 1) ? g.fb1 : g.fb0, ((CB) >> 1) + (i >> 1)); \
                C0 = fa * C0 + fb * pg8::bflo(U[i].x); C1 = fa * C1 + fb * pg8::bfhi(U[i].x); C2 = fa * C2 + fb * pg8::bflo(U[i].y); C3 = fa * C3 + fb * pg8::bfhi(U[i].y); }
#pragma unroll 1
        for (int c8 = 0; c8 < NC; c8 += 32) {
#pragma unroll
            for (int i = 0; i < 16; ++i) ub[i] = *(const v2u*)(UB + base + (size_t)(c8 + 16 + i) * 65536);
            SCAN_STEPS(ua, c8)
            if (c8 + 32 < NC) {
#pragma unroll
                for (int i = 0; i < 16; ++i) ua[i] = *(const v2u*)(UB + base + (size_t)(c8 + 32 + i) * 65536); }
            SCAN_STEPS(ub, c8 + 16)
        }
#undef SCAN_STEPS
    } else if (gt < 65536 + 256) {
        const int idx = gt - 65536, h = idx >> 6, d0 = 4 * (idx & 63);
        f32x4 ua[16], ub[16];
#pragma unroll
        for (int i = 0; i < 16; ++i) ua[i] = *(const f32x4*)(NU + ((size_t)h * NC + i) * 256 + d0);
        const GateTab g = gate_tables(BL, ML, h, lane);
        f32x4 n = {0.f, 0.f, 0.f, 0.f};
#define NSCAN_STEPS(U, CB) _Pragma("unroll") for (int i = 0; i < 16; ++i) { \
                *(f32x4*)(NST + ((size_t)h * NC + (CB) + i) * 256 + d0) = n; \
                const float fa = rdl((i & 1) ? g.fa1 : g.fa0, ((CB) >> 1) + (i >> 1)), fb = rdl((i & 1) ? g.fb1 : g.fb0, ((CB) >> 1) + (i >> 1)); \
                n = fa * n + fb * U[i]; }
#pragma unroll 1
        for (int c8 = 0; c8 < NC; c8 += 32) {
#pragma unroll
            for (int i = 0; i < 16; ++i) ub[i] = *(const f32x4*)(NU + ((size_t)h * NC + c8 + 16 + i) * 256 + d0);
            NSCAN_STEPS(ua, c8)
            if (c8 + 32 < NC) {
#pragma unroll
                for (int i = 0; i < 16; ++i) ua[i] = *(const f32x4*)(NU + ((size_t)h * NC + c8 + 32 + i) * 256 + d0); }
            NSCAN_STEPS(ub, c8 + 16)
        }
#undef NSCAN_STEPS
    }
}
constexpr int ST3 = 528;
constexpr int K3_OFF = 0, V3_OFF = 128 * ST3, T3_OFF = 2 * 128 * ST3;
__device__ __forceinline__ void step3_unit(const Ctx& F, int h, int c, const bf16* MQ, const bf16* MK, const bf16* MV, const bf16* CST, const float* NST, const float* MP, const float* AA, const float* BC,
                                           const bf16* MO, const float* mhg, bf16* Y) {
    LAS unsigned char* lds = F.lds; const int lane = lane_id_opaque(), wid = F.wave, tid = wid * 64 + lane, r32 = lane & 31, hi = lane >> 5;
    const int t0 = c * L;
    LAS float* aat = (LAS float*)(lds + T3_OFF); LAS float* att_ = aat + 128; LAS float* ait = aat + 256; LAS float* nvt = aat + 384; LAS float* pst = aat + 640; LAS float* rvt = aat + 896;
    const size_t gi = (size_t)h * S_ + t0 + 2 * lane; float a0 = 0.f, a1 = 0.f, mp = 0.f; f32x4 nv4 = {0.f, 0.f, 0.f, 0.f};
    if (wid == 0) { a0 = AA[gi]; a1 = AA[gi + 1]; mp = MP[h * NC + c]; }
    if (wid == 1) nv4 = *(const f32x4*)(NST + ((size_t)h * NC + c) * 256 + 4 * lane);
    const int rg = wid >> 1, eh = wid & 1; const int tr = 32 * rg + r32;
    const float bcv = BC[(size_t)h * S_ + t0 + tr];
    float gm[4];
#pragma unroll
    for (int db = 0; db < 4; ++db) gm[db] = mhg[128 * eh + 32 * db + r32];
    bf16x8 qf[16];
    { const bf16* qp = MQ + (size_t)(t0 + tr) * 1024 + h * 256 + 8 * hi;
#pragma unroll
      for (int k0 = 0; k0 < 16; ++k0) qf[k0] = *(const bf16x8*)(qp + 16 * k0); }
    { const bf16* cbase = CST + ((size_t)h * NC + c) * 65536;
#pragma unroll
      for (int i = 0; i < 16; ++i) { const int idx = tid + 512 * i, row = idx >> 5, pc = idx & 31;
          *(LAS v4u*)(lds + row * ST3 + pc * 16) = *(const v4u*)(cbase + (size_t)row * 256 + pc * 8); } }
    if (wid == 0) {
        float s = fmaxf(a0, a1);
#pragma unroll
        for (int o = 1; o < 64; o <<= 1) { const float y = bperm(s, lane - o); if (lane >= o) s = fmaxf(s, y); }
        float prev = bperm(s, lane - 1); if (lane == 0) prev = -INFINITY;
        const float A0 = fmaxf(mp, fmaxf(prev, a0)), A1 = fmaxf(mp, s);
        aat[2 * lane] = a0; aat[2 * lane + 1] = a1; att_[2 * lane] = A0; att_[2 * lane + 1] = A1; ait[2 * lane] = __expf(mp - A0); ait[2 * lane + 1] = __expf(mp - A1);
    }
    if (wid == 1) *(LAS f32x4*)(nvt + 4 * lane) = nv4;
    __syncthreads();
    v4u kreg[8], vreg[8];
#pragma unroll
    for (int i = 0; i < 8; ++i) { const int idx = tid + 512 * i, row = idx >> 5, pc = idx & 31;
        kreg[i] = *(const v4u*)(MK + (size_t)(t0 + row) * 1024 + h * 256 + pc * 8); vreg[i] = *(const v4u*)(MV + (size_t)(t0 + row) * 1024 + h * 256 + pc * 8); }
    f32x16 acc[4];
#pragma unroll
    for (int db = 0; db < 4; ++db) acc[db] = f32x16{};
    { const LAS unsigned char* cb = lds + (128 * eh + r32) * ST3 + 16 * hi;
#pragma unroll
      for (int k0 = 0; k0 < 16; ++k0) {
          bf16x8 cf[4];
#pragma unroll
          for (int db = 0; db < 4; ++db) cf[db] = *(const LAS bf16x8*)(cb + (32 * db) * ST3 + 32 * k0);
#pragma unroll
          for (int db = 0; db < 4; ++db) acc[db] = MFMA32(qf[k0], cf[db], acc[db]);
      }
    }
#pragma unroll
    for (int r = 0; r < 16; ++r) { const float a = ait[32 * rg + crow(r, hi)];
#pragma unroll
        for (int db = 0; db < 4; ++db) acc[db][r] *= a; }
    __syncthreads();
#pragma unroll
    for (int i = 0; i < 8; ++i) { const int idx = tid + 512 * i, row = idx >> 5, pc = idx & 31;
        *(LAS v4u*)(lds + K3_OFF + row * ST3 + pc * 16) = kreg[i]; *(LAS v4u*)(lds + V3_OFF + row * ST3 + pc * 16) = vreg[i]; }
    __syncthreads();
    float nq = 0.f;
#pragma unroll
    for (int k0 = 0; k0 < 16; ++k0) { const v4u w = __builtin_bit_cast(v4u, qf[k0]); const LAS float* np = nvt + 16 * k0 + 8 * hi;
        nq += pg8::bflo(w.x) * np[0] + pg8::bfhi(w.x) * np[1] + pg8::bflo(w.y) * np[2] + pg8::bfhi(w.y) * np[3] + pg8::bflo(w.z) * np[4] + pg8::bfhi(w.z) * np[5] + pg8::bflo(w.w) * np[6] + pg8::bfhi(w.w) * np[7]; }
    nq = swap_add(nq);
    const float At = att_[tr];
    float dsum = 0.f;
    const LAS unsigned char* vb = lds + V3_OFF + (4 * hi + ((lane & 15) >> 2)) * ST3 + (128 * eh + 16 * ((lane >> 4) & 1) + 4 * (lane & 3)) * 2;
    for (int kt = 0; kt <= (rg >> 1); ++kt) {
        f32x16 p0 = f32x16{}, p1 = f32x16{};
        const LAS unsigned char* kb = lds + K3_OFF + (64 * kt + r32) * ST3 + 16 * hi;
#pragma unroll
        for (int k0 = 0; k0 < 16; ++k0) { const bf16x8 ka = *(const LAS bf16x8*)(kb + 32 * k0), kc = *(const LAS bf16x8*)(kb + 32 * ST3 + 32 * k0);
            p0 = MFMA32(ka, qf[k0], p0); p1 = MFMA32(kc, qf[k0], p1); }
#pragma unroll
        for (int r = 0; r < 16; ++r) { const int s0 = 64 * kt + crow(r, hi), s1 = s0 + 32;
            const float w0 = s0 <= tr ? __builtin_amdgcn_exp2f((aat[s0] - At) * LOG2E_) : 0.f, w1 = s1 <= tr ? __builtin_amdgcn_exp2f((aat[s1] - At) * LOG2E_) : 0.f;
            p0[r] *= w0; p1[r] *= w1; dsum += p0[r] + p1[r]; }
        v4u pw[4];
        pw[0] = (v4u){pk2(p0[0], p0[1]), pk2(p0[2], p0[3]), pk2(p0[4], p0[5]), pk2(p0[6], p0[7])};
        pw[1] = (v4u){pk2(p0[8], p0[9]), pk2(p0[10], p0[11]), pk2(p0[12], p0[13]), pk2(p0[14], p0[15])};
        pw[2] = (v4u){pk2(p1[0], p1[1]), pk2(p1[2], p1[3]), pk2(p1[4], p1[5]), pk2(p1[6], p1[7])};
        pw[3] = (v4u){pk2(p1[8], p1[9]), pk2(p1[10], p1[11]), pk2(p1[12], p1[13]), pk2(p1[14], p1[15])};
#pragma unroll
        for (int ks = 0; ks < 4; ++ks)
#pragma unroll
            for (int db = 0; db < 4; ++db) { const bf16x8 vf = tr8(vb + (64 * kt + 16 * ks) * ST3 + db * 64, 8 * ST3); acc[db] = MFMA32(__builtin_bit_cast(bf16x8, pw[ks]), vf, acc[db]); }
    }
    v2u mo[8];
#pragma unroll
    for (int i = 0; i < 8; ++i) { const int p = lane + 64 * i; mo[i] = *(const v2u*)((const unsigned char*)MO + (size_t)(t0 + 32 * rg + (p >> 4)) * 1024 + h * 256 + 128 * eh + 8 * (p & 15)); }
    dsum = swap_add(dsum);
    { const float den = dsum + ait[tr] * nq; const float mt = bcv + At;
      if (hi == 0) rvt[wid * 32 + r32] = 1.0f / fmaxf(fabsf(den), __expf(-mt)); }
    LDS_WAIT(); asm volatile("" ::: "memory");
    float rv[16];
#pragma unroll
    for (int r = 0; r < 16; ++r) { rv[r] = rvt[wid * 32 + crow(r, hi)]; float ss = 0.f;
#pragma unroll
        for (int db = 0; db < 4; ++db) { acc[db][r] *= rv[r]; ss += acc[db][r] * acc[db][r]; }
        ss = half_sum(ss); if (r32 == 0) pst[wid * 32 + crow(r, hi)] = ss; }
    __syncthreads();
    LAS unsigned char* stg = lds + K3_OFF + wid * 8704;
#pragma unroll
    for (int r = 0; r < 16; ++r) { const int row = crow(r, hi); const float tot = pst[wid * 32 + row] + pst[(wid ^ 1) * 32 + row];
        const float rs = __builtin_amdgcn_rsqf(tot * (1.0f / 256.0f) + EPS_);
#pragma unroll
        for (int db = 0; db < 4; ++db) *(LAS bf16*)(stg + row * 272 + (32 * db + r32) * 2) = f2bf(acc[db][r] * rs * gm[db]); }
    LDS_WAIT(); asm volatile("" ::: "memory");
#pragma unroll
    for (int i = 0; i < 8; ++i) { const int p = lane + 64 * i, row = p >> 4, ch = p & 15;
        const v4u hv = *(const LAS v4u*)(stg + row * 272 + ch * 16); const v2u mv = mo[i]; v4u o; const float gs_ = DBG_MLS_SCALE * (1.0f / 255.0f);
        o.x = pk2(gs_ * pg8::bflo(hv.x) * ubf(mv.x, 0), gs_ * pg8::bfhi(hv.x) * ubf(mv.x, 1)); o.y = pk2(gs_ * pg8::bflo(hv.y) * ubf(mv.x, 2), gs_ * pg8::bfhi(hv.y) * ubf(mv.x, 3));
        o.z = pk2(gs_ * pg8::bflo(hv.z) * ubf(mv.y, 0), gs_ * pg8::bfhi(hv.z) * ubf(mv.y, 1)); o.w = pk2(gs_ * pg8::bflo(hv.w) * ubf(mv.y, 2), gs_ * pg8::bfhi(hv.w) * ubf(mv.y, 3));
        *(v4u*)(Y + (size_t)(t0 + 32 * rg + row) * 2048 + 1024 + h * 256 + 128 * eh + 8 * ch) = o; }
    __syncthreads();
}
}

#ifndef REPMASK
#define REPMASK 0
#endif
#ifndef PHMASK
#define PHMASK 0x3fff
#endif
constexpr int NPH_LAYER = 12, NPHASES = 2 + DEPTH_ * NPH_LAYER;
struct Args { const float* in[22]; float* out; unsigned char* ws; int ph_lo, ph_hi; };
__global__ void __launch_bounds__(512, 2) fwd(Args args) {
    extern __shared__ __attribute__((aligned(16))) unsigned char lds_raw[];
    Ctx F;
    F.lds = (LAS unsigned char*)lds_raw;
    F.tid = threadIdx.x; F.lane = F.tid & 63; F.wave = __builtin_amdgcn_readfirstlane(F.tid >> 6);
    F.G = gridDim.x; { const int bx = blockIdx.x; F.vcu = (F.G % 8 == 0) ? (bx % 8) * (F.G / 8) + bx / 8 : bx; }
    volatile LAS unsigned* MISC = (volatile LAS unsigned*)(F.lds + MISC_OFF);
    if (F.tid < 64) MISC[F.tid] = 0u;
    __syncthreads();
    unsigned char* ws = args.ws;
    const int lo = args.ph_lo, hi = args.ph_hi;
    const bool use_bar = (hi - lo) > 1;
    XcdBarrier bar; bar.bar = (unsigned*)(ws + WS_CTL) + 1024; bar.x = 0; bar.st = nullptr;
    if (use_bar) bar = xcd_barrier_post((unsigned*)(ws + WS_CTL) + 1024, MISC + 8);
#define IN(k) (lo <= (k) && (k) < hi)
#define FRESH(Fx) Ctx Fx = F; Fx.lane = lane_id_opaque(); Fx.tid = Fx.wave * 64 + Fx.lane; asm volatile("" : "+s"(Fx.vcu), "+s"(Fx.G)); unsigned char* wsl = ws; asm volatile("" : "+s"(wsl)); int lq = l; asm volatile("" : "+s"(lq))
#define SEAM_(k, X) do { if (IN((k) + 1)) { XcdBarrier b_ = bar; asm volatile("" : "+s"(b_.bar)); xcd_barrier<X>(b_, F.wave == 0 && lane_id_opaque() == 0); } } while (0)
#define SEAM(k) SEAM_(k, false)
    const float* const* in = args.in;
    float* xout = args.out;
#define P_BF(off) ((bf16*)(wsl + (off)))
#define P_F32(off) ((float*)(wsl + (off)))
#define L_MOD ((const float*)(wsl + WS_MOD) + lq * 6144)
#define L_PAR ((const float*)(wsl + WS_PAR) + (size_t)lq * PAR_L)
#define L_WL (wsl + ((lq & 1) ? WS_W2 : WS_W))
#define L_XSRC ((lq == 0) ? in[0] : xout)
#define L_B1(ll) ((u64*)(wsl + WS_B1) + ((ll) & 1) * 4096)
    if (IN(0) && (PHMASK >> 12 & 1)) { prologue_a(F, in[1], in[2], (float*)(ws + WS_MODP)); wconv_layer(F, in, ws + WS_W, 0, 0, nullptr, nullptr, nullptr, 1);     SEAM(0); }
    if (IN(1) && (PHMASK >> 13 & 1)) { prologue_b(F, in, ws); __syncthreads(); SEAM(1); }

    for (int l = 0; l < DEPTH_; ++l) {
        const int pb = 2 + NPH_LAYER * l;
        if (IN(pb + 0) && (PHMASK >> 0 & 1)) { FRESH(Fp);
          _Pragma("unroll 1") for (int rep_ = 0; rep_ < 1 + ((REPMASK >> 0) & 1); ++rep_) {
            if (lq == 0) wconv_layer(Fp, in, L_WL, 0, 0, L_PAR, L_MOD, L_B1(0), 2);
            norm_phase<true>(Fp, L_XSRC, P_BF(WS_XN), L_PAR + PR_NMG, L_MOD + 0, L_MOD + 1024, L_PAR + PR_GW, L_PAR + PR_BIG, L_PAR + PR_BFG, P_F32(WS_IG), P_F32(WS_LF), (u64*)(wsl + WS_SS), L_B1(lq + 1), wsl + WS_YAM);
            SEAM(pb + 0);
          }
        }
        if (IN(pb + 1) && (PHMASK >> 1 & 1)) { FRESH(Fp);
          _Pragma("unroll 1") for (int rep_ = 0; rep_ < 1 + ((REPMASK >> 1) & 1); ++rep_) {
            pg8::EpiProj E{wsl, L_PAR + PR_QNG, L_PAR + PR_KNG};
#if PROJ8
            {
                constexpr int NT8 = 36 - (P8_HI - P8_LO); pg8::Gemm g{P_BF(WS_YAM), (const bf16*)(L_WL + W_IN), S_, NT8 * 256, 512, 1024, 1024}; pg8::SubsetOrder<P8_LO, P8_HI - P8_LO> So; So.init(S_, NT8 * 256, Fp.G, (int)blockIdx.x);
                pg8::gemm_phase<pg8::EpiProj, pg8::SubsetOrder<P8_LO, P8_HI - P8_LO>, true, true, true>(Fp.lds, g, So, E, Fp.wave); }
#if P8_HI > P8_LO
            {
                constexpr int NTB = P8_HI - P8_LO; pg8::Gemm g{P_BF(WS_XN), (const bf16*)(L_WL + W_IN), S_, NTB * 256, 1024, 1024, 1024}; pg8::SubsetOrder<0, P8_LO> So; So.init(S_, NTB * 256, Fp.G, (int)blockIdx.x);
                pg8::gemm_phase<pg8::EpiProj, pg8::SubsetOrder<0, P8_LO>, true, true>(Fp.lds, g, So, E, Fp.wave); }
#endif
#else
            { pg8::Gemm g{P_BF(WS_XN), (const bf16*)(L_WL + W_IN), S_, NIN_, 1024, 1024, 1024}; pg8::StaticOrder So; So.init(S_, NIN_, Fp.G, (int)blockIdx.x);
              pg8::gemm_phase<pg8::EpiProj, pg8::StaticOrder, true, true>(Fp.lds, g, So, E, Fp.wave); }
#endif
            SEAM(pb + 1);
          }
        }
        if (IN(pb + 2) && (PHMASK >> 2 & 1)) { FRESH(Fp);
          _Pragma("unroll 1") for (int rep_ = 0; rep_ < 1 + ((REPMASK >> 2) & 1); ++rep_) {
            const float* lt = (const float*)(wsl + WS_TAB + 4096) + lq * 4; const float lam = __uint_as_float(__builtin_amdgcn_readfirstlane(__float_as_uint(lt[0]))), oml = __uint_as_float(__builtin_amdgcn_readfirstlane(__float_as_uint(lt[1])));
            if (Fp.wave >= 4) __builtin_amdgcn_s_setprio(1);
            for (int p = Fp.vcu; p < 256; p += Fp.G) {
                const int h = p >> 5, s = p & 31;
#pragma unroll 1
                for (int i = 0; i < 2; ++i)
                    att::attn_unit(Fp, h, i ? s : 63 - s, P_BF(WS_Q), (const unsigned char*)(wsl + WS_K), (const unsigned char*)(wsl + WS_V8T), P_BF(WS_YAM), (const float*)(wsl + WS_TAB) + h * 128, lam, oml, L_PAR + PR_SUBG);
            }
            __builtin_amdgcn_s_setprio(0);
            SEAM_(pb + 2, true);
          }
        }
        if (IN(pb + 3) && (PHMASK >> 3 & 1)) { FRESH(Fp);
          _Pragma("unroll 1") for (int rep_ = 0; rep_ < 1 + ((REPMASK >> 3) & 1); ++rep_) {
            for (int u = Fp.vcu; u < 4 * mls::NC; u += Fp.G)
                mls::step1_unit(Fp, lq, u >> 7, u & 127, P_F32(WS_LF), P_F32(WS_IG), P_F32(WS_BC), P_F32(WS_AA), P_F32(WS_BL), P_F32(WS_ML), P_BF(WS_MQKR), P_BF(WS_MV), P_BF(WS_MQ), P_BF(WS_MK), L_PAR + PR_CONVW, L_PAR + PR_CONVB, P_BF(WS_UB), P_F32(WS_NU));
            SEAM(pb + 3);
          }
        }
        if (IN(pb + 4) && (PHMASK >> 4 & 1)) { FRESH(Fp);
            _Pragma("unroll 1") for (int rep_ = 0; rep_ < 1 + ((REPMASK >> 4) & 1); ++rep_) { if (Fp.vcu < 129 || lq + 1 >= DEPTH_) mls::scan_phase(Fp, P_BF(WS_UB), P_BF(WS_CST), P_F32(WS_BL), P_F32(WS_ML), P_F32(WS_MP), P_F32(WS_NU), P_F32(WS_NST));
                else wconv_layer(Fp, in, wsl + (((lq + 1) & 1) ? WS_W2 : WS_W), lq + 1, 129, (const float*)(wsl + WS_PAR) + (size_t)(lq + 1) * PAR_L, (const float*)(wsl + WS_MOD) + (lq + 1) * 6144, L_B1(lq + 1));
                SEAM(pb + 4);  }
        }
        if (IN(pb + 5) && (PHMASK >> 5 & 1)) { FRESH(Fp);
          _Pragma("unroll 1") for (int rep_ = 0; rep_ < 1 + ((REPMASK >> 5) & 1); ++rep_) {
            for (int u = Fp.vcu; u < 4 * mls::NC; u += Fp.G)
                mls::step3_unit(Fp, u >> 7, u & 127, P_BF(WS_MQ), P_BF(WS_MK), P_BF(WS_MV), P_BF(WS_CST), P_F32(WS_NST), P_F32(WS_MP), P_F32(WS_AA), P_F32(WS_BC), P_BF(WS_MO), L_PAR + PR_MHG, P_BF(WS_YAM));
            SEAM(pb + 5);
          }
        }
        if (IN(pb + 6) && (PHMASK >> 6 & 1)) { FRESH(Fp);
          _Pragma("unroll 1") for (int rep_ = 0; rep_ < 1 + ((REPMASK >> 6) & 1); ++rep_) {
            pg8::Gemm g{P_BF(WS_YAM), (const bf16*)(L_WL + W_A), S_, 1024, 2048, 2048, 2048}; pg8::StaticOrder So; So.init(S_, 1024, Fp.G, (int)blockIdx.x);
            pg8::EpiMerge E{P_BF(WS_XN), 1024, P_BF(WS_GAM), 2048};
            pg8::gemm_phase<pg8::EpiMerge, pg8::StaticOrder, true, true>(Fp.lds, g, So, E, Fp.wave);
            SEAM(pb + 7);
          }
        }
        if (IN(pb + 8) && (PHMASK >> 8 & 1)) { FRESH(Fp);
          _Pragma("unroll 1") for (int rep_ = 0; rep_ < 1 + ((REPMASK >> 8) & 1); ++rep_) {
            { const int gt = Fp.vcu * 512 + Fp.tid; if (gt < 4096) P_F32(WS_B1F)[gt] = fx_dec(L_B1(lq)[gt], 1.0f / B1Q_); }
            pg8::Gemm g{P_BF(WS_XN), (const bf16*)(L_WL + W_OUT), S_, 1024, 1024, 1024, 1024}; pg8::StaticOrder So; So.init(S_, 1024, Fp.G, (int)blockIdx.x);
            pg8::EpiResid<true> E{L_XSRC, xout, 1024, L_MOD + 2048, P_BF(WS_XB), (u64*)(wsl + WS_SS)};
            pg8::gemm_phase<pg8::EpiResid<true>, pg8::StaticOrder, true, true>(Fp.lds, g, So, E, Fp.wave);
            SEAM(pb + 9);
          }
        }
        if (IN(pb + 10) && (PHMASK >> 10 & 1)) { FRESH(Fp);
          _Pragma("unroll 1") for (int rep_ = 0; rep_ < 1 + ((REPMASK >> 10) & 1); ++rep_) {
            pg8::Gemm g{P_BF(WS_XB), (const bf16*)(L_WL + W_F1), S_, DFF_, 1024, 1024, 1024}; pg8::StaticOrder So; So.init(S_, DFF_, Fp.G, (int)blockIdx.x);
            pg8::EpiRelu2 E{P_BF(WS_FFU), DFF_, (u64*)(wsl + WS_SS), P_F32(WS_B1F)};
            pg8::gemm_phase<pg8::EpiRelu2, pg8::StaticOrder, true, true>(Fp.lds, g, So, E, Fp.wave);
            SEAM(pb + 10);
          }
        }
        if (IN(pb + 11) && (PHMASK >> 11 & 1)) { FRESH(Fp);
          _Pragma("unroll 1") for (int rep_ = 0; rep_ < 1 + ((REPMASK >> 11) & 1); ++rep_) {
            pg8::Gemm g{P_BF(WS_FFU), (const bf16*)(L_WL + W_F2), S_, 1024, DFF_, DFF_, DFF_}; pg8::StaticOrder So; So.init(S_, 1024, Fp.G, (int)blockIdx.x);
            pg8::EpiResid<false> E{xout, xout, 1024, L_MOD + 5120, nullptr, nullptr};
            pg8::gemm_phase<pg8::EpiResid<false>, pg8::StaticOrder, true, true>(Fp.lds, g, So, E, Fp.wave);
            SEAM(pb + 11);
          }
        }
    }
#undef IN
#undef SEAM
}

#ifndef MK_ONE_LAUNCH
#define MK_ONE_LAUNCH 1
#endif
extern "C" void kernel_launch(void* const* d_in, const int* in_sizes, int n_in, void* d_out, int out_size, void* d_ws, size_t ws_size, hipStream_t stream) {
    constexpr int grid = 256;
    static int once = 0;
    if (!once) { once = 1; (void)hipFuncSetAttribute((const void*)fwd, hipFuncAttributeMaxDynamicSharedMemorySize, LDS_BYTES); }
    if (ws_size < WS_END || n_in != 22) return;
    (void)hipMemsetAsync((char*)d_ws + WS_CTL, 0, CTL_ZERO_BYTES, stream);
    Args a{};
    for (int i = 0; i < 22; ++i) a.in[i] = (const float*)d_in[i];
    a.out = (float*)d_out; a.ws = (unsigned char*)d_ws;
#if MK_ONE_LAUNCH
    a.ph_lo = 0; a.ph_hi = NPHASES;
    hipLaunchKernelGGL(fwd, dim3(grid), dim3(512), LDS_BYTES, stream, a);
#else
    for (int p = 0; p < NPHASES; ++p) { a.ph_lo = p; a.ph_hi = p + 1; hipLaunchKernelGGL(fwd, dim3(grid), dim3(512), LDS_BYTES, stream, a); }
#endif
}
```
